# Optimizing an MI355X kernel written in HIP

```python
import math
import jax, jax.numpy as jnp
from jax import lax
import numpy as np

D_MODEL = 2048
BATCH = 4
SEQ = 2048
DEPTH = 1

N_MEM = 256
HEAD_DIM = D_MODEL // 16
BRANCH_W = D_MODEL // 2
N_BRANCH = 3
DIFF_HEADS = 8
DIFF_QK = HEAD_DIM // 2
DIFF_V = HEAD_DIM
WIN_HEADS = 8
WIN_KV_HEADS = 2
WIN_DIM = HEAD_DIM
WINDOW = 128
BLOCK = 128
MEM_HEADS = 4
MEM_DIM = BRANCH_W // MEM_HEADS
SEG_DIFF_Q = DIFF_HEADS * 2 * DIFF_QK
SEG_DIFF_K = DIFF_HEADS * 2 * DIFF_QK
SEG_DIFF_V = DIFF_HEADS * DIFF_V
SEG_WIN_Q = WIN_HEADS * WIN_DIM
SEG_WIN_K = WIN_KV_HEADS * WIN_DIM
SEG_WIN_V = WIN_KV_HEADS * WIN_DIM
SEG_MEM_Q = MEM_HEADS * MEM_DIM
SEGMENTS = (SEG_DIFF_Q, SEG_DIFF_K, SEG_DIFF_V, SEG_WIN_Q, SEG_WIN_K, SEG_WIN_V, SEG_MEM_Q)
IN_W = SEG_DIFF_Q + SEG_DIFF_K + SEG_DIFF_V + SEG_WIN_Q + SEG_WIN_K + SEG_WIN_V + SEG_MEM_Q
D_FF = 5504
CONV_W = 3
REL_BUCKETS = 32
REL_MAX_DIST = 128
REL_HEADS = DIFF_HEADS + WIN_HEADS
ALPHA = (2 * DEPTH) ** 0.25
BETA = (8 * DEPTH) ** -0.25
LN_EPS = 1e-5
NEG = -1e30

kernel_name = "hybrid_diffattn_wingqa_mem_convffn_deepnorm"


def layer_norm(x, g, b):
    xf = x.astype(jnp.float32)
    mu = jnp.mean(xf, axis=-1, keepdims=True)
    var = jnp.mean(jnp.square(xf - mu), axis=-1, keepdims=True)
    return ((xf - mu) * lax.rsqrt(var + LN_EPS) * g.astype(jnp.float32) + b.astype(jnp.float32)).astype(x.dtype)


def rms_norm(x, g):
    xf = x.astype(jnp.float32)
    ms = jnp.mean(jnp.square(xf), axis=-1, keepdims=True)
    return (xf * lax.rsqrt(ms + LN_EPS) * g.astype(jnp.float32)).astype(x.dtype)


def t5_bucket(rel):
    half = REL_BUCKETS // 2
    max_exact = half // 2
    ret = jnp.where(rel > 0, half, 0)
    n = jnp.abs(rel)
    nf = jnp.maximum(n, 1).astype(jnp.float32)
    large = max_exact + (jnp.log(nf / max_exact) / math.log(REL_MAX_DIST / max_exact)
                         * (half - max_exact)).astype(jnp.int32)
    large = jnp.minimum(large, half - 1)
    return ret + jnp.where(n < max_exact, n, large)


def diff_attention(q, k, v, lq1, lk1, lq2, lk2, subln_g, rel_table, lambda_init):
    B, S = q.shape[0], q.shape[1]
    nblk = S // BLOCK
    lam = (jnp.exp(jnp.sum(lq1.astype(jnp.float32) * lk1.astype(jnp.float32)))
           - jnp.exp(jnp.sum(lq2.astype(jnp.float32) * lk2.astype(jnp.float32))) + lambda_init)
    scale = DIFF_QK ** -0.5
    table = rel_table[:, :DIFF_HEADS].astype(jnp.float32)
    kpos = jnp.arange(S)

    def one_block(i):
        qb = lax.dynamic_slice_in_dim(q, i * BLOCK, BLOCK, axis=1)
        qpos = i * BLOCK + jnp.arange(BLOCK)
        bias = jnp.transpose(table[t5_bucket(kpos[None, :] - qpos[:, None])], (2, 0, 1))
        s = jnp.einsum('bqhcd,bkhcd->bhcqk', qb, k).astype(jnp.float32) * scale + bias[None, :, None]
        p = jax.nn.softmax(s, axis=-1)
        a = p[:, :, 0] - lam * p[:, :, 1]
        return jnp.einsum('bhqk,bkhd->bqhd', a.astype(v.dtype), v)

    o = lax.map(one_block, jnp.arange(nblk))
    o = jnp.transpose(o, (1, 0, 2, 3, 4)).reshape(B, S, DIFF_HEADS, DIFF_V)
    o = rms_norm(o, subln_g) * (1.0 - lambda_init)
    return o.reshape(B, S, DIFF_HEADS * DIFF_V)


def windowed_gqa(q, k, v, sink, rel_table):
    B, S = q.shape[0], q.shape[1]
    nblk = S // BLOCK
    G = WIN_HEADS // WIN_KV_HEADS
    scale = WIN_DIM ** -0.5
    qb = q.reshape(B, nblk, BLOCK, WIN_KV_HEADS, G, WIN_DIM)

    def band(t):
        tp = jnp.pad(t, ((0, 0), (WINDOW, WINDOW), (0, 0), (0, 0)))
        tb = tp.reshape(B, nblk + 2, BLOCK, WIN_KV_HEADS, WIN_DIM)
        return jnp.concatenate([tb[:, :-2], tb[:, 1:-1], tb[:, 2:]], axis=2)

    kb, vb = band(k), band(v)
    blk = jnp.arange(nblk)[:, None] * BLOCK
    qpos = blk + jnp.arange(BLOCK)[None, :]
    kpos = blk - WINDOW + jnp.arange(3 * BLOCK)[None, :]
    rel = kpos[:, None, :] - qpos[:, :, None]
    valid = (jnp.abs(rel) <= WINDOW) & (kpos[:, None, :] >= 0) & (kpos[:, None, :] < S)
    bias = rel_table[:, DIFF_HEADS:].astype(jnp.float32)[t5_bucket(rel)]
    bias = jnp.transpose(bias.reshape(nblk, BLOCK, 3 * BLOCK, WIN_KV_HEADS, G), (3, 4, 0, 1, 2))
    s = jnp.einsum('bnqhgd,bnkhd->bhgnqk', qb, kb).astype(jnp.float32) * scale + bias[None]
    s = jnp.where(valid, s, NEG)
    sk = sink.astype(jnp.float32).reshape(WIN_KV_HEADS, G)[None, :, :, None, None, None]
    m = jnp.maximum(jnp.max(s, axis=-1, keepdims=True), sk)
    p = jnp.exp(s - m)
    p = p / (jnp.sum(p, axis=-1, keepdims=True) + jnp.exp(sk - m))
    o = jnp.einsum('bhgnqk,bnkhd->bnqhgd', p.astype(v.dtype), vb)
    return o.reshape(B, S, WIN_HEADS * WIN_DIM)


def memory_attention(q, mk, mv):
    B, S = q.shape[0], q.shape[1]
    s = jnp.einsum('bqhd,bkhd->bhqk', q, mk).astype(jnp.float32) * (MEM_DIM ** -0.5)
    p = jax.nn.softmax(s, axis=-1)
    o = jnp.einsum('bhqk,bkhd->bqhd', p.astype(mv.dtype), mv)
    return o.reshape(B, S, MEM_HEADS * MEM_DIM)


def conv_ffn(h, w_up, conv_w, conv_b, w_down):
    u = h @ w_up
    up = jnp.pad(u, ((0, 0), (1, 1), (0, 0)))
    u = up[:, :-2] * conv_w[0] + up[:, 1:-1] * conv_w[1] + up[:, 2:] * conv_w[2] + conv_b
    val, gate = jnp.split(u, 2, axis=-1)
    return (jax.nn.gelu(gate) * val) @ w_down


def setup_inputs(seed: int = 0) -> dict:
    key = jax.random.key(seed)
    ks = jax.random.split(key, 26)
    f32 = jnp.float32
    nrm = lambda k, shape: jax.random.normal(k, shape, f32)
    D = D_MODEL
    col_scale = jnp.concatenate([
        jnp.full((SEG_DIFF_Q + SEG_DIFF_K,), 1.0, f32),
        jnp.full((SEG_DIFF_V,), BETA, f32),
        jnp.full((SEG_WIN_Q + SEG_WIN_K,), 1.0, f32),
        jnp.full((SEG_WIN_V,), BETA, f32),
        jnp.full((SEG_MEM_Q,), 1.0, f32)]) * (D ** -0.5)
    mem_scale = jnp.concatenate([jnp.full((BRANCH_W,), 1.0, f32), jnp.full((BRANCH_W,), BETA, f32)]) * (D ** -0.5)
    return {
        "x": nrm(ks[0], (BATCH, SEQ, D)),
        "mem": nrm(ks[1], (BATCH, N_MEM, D)),
        "ln_in_g": 1.0 + 0.02 * nrm(ks[2], (D,)),
        "ln_in_b": 0.02 * nrm(ks[3], (D,)),
        "rel_table": 0.2 * nrm(ks[4], (REL_BUCKETS, REL_HEADS)),
        "w_in": nrm(ks[5], (DEPTH, D, IN_W)) * col_scale,
        "w_mem_kv": nrm(ks[6], (DEPTH, D, 2 * BRANCH_W)) * mem_scale,
        "diff_lq1": 0.1 * nrm(ks[7], (DEPTH, DIFF_QK)),
        "diff_lk1": 0.1 * nrm(ks[8], (DEPTH, DIFF_QK)),
        "diff_lq2": 0.1 * nrm(ks[9], (DEPTH, DIFF_QK)),
        "diff_lk2": 0.1 * nrm(ks[10], (DEPTH, DIFF_QK)),
        "diff_subln_g": 1.0 + 0.02 * nrm(ks[11], (DEPTH, DIFF_V)),
        "win_sink": 0.5 * nrm(ks[12], (DEPTH, WIN_HEADS)),
        "w_gate": nrm(ks[13], (DEPTH, D, N_BRANCH * D)) * (D ** -0.5),
        "b_gate": 0.02 * nrm(ks[14], (DEPTH, N_BRANCH * D)),
        "w_branch": nrm(ks[15], (DEPTH, N_BRANCH, BRANCH_W, D)) * (BRANCH_W ** -0.5),
        "w_o": nrm(ks[16], (DEPTH, D, D)) * (BETA * D ** -0.5),
        "ln1_g": 1.0 + 0.02 * nrm(ks[17], (DEPTH, D)),
        "ln1_b": 0.02 * nrm(ks[18], (DEPTH, D)),
        "w_up": nrm(ks[19], (DEPTH, D, 2 * D_FF)) * (D ** -0.5),
        "conv_w": nrm(ks[20], (DEPTH, CONV_W, 2 * D_FF)) * (CONV_W ** -0.5),
        "conv_b": 0.02 * nrm(ks[21], (DEPTH, 2 * D_FF)),
        "w_down": nrm(ks[22], (DEPTH, D_FF, D)) * (BETA * D_FF ** -0.5),
        "ln2_g": 1.0 + 0.02 * nrm(ks[23], (DEPTH, D)),
        "ln2_b": 0.02 * nrm(ks[24], (DEPTH, D)),
    }


def reference(x, mem, ln_in_g, ln_in_b, rel_table, w_in, w_mem_kv, diff_lq1, diff_lk1, diff_lq2,
              diff_lk2, diff_subln_g, win_sink, w_gate, b_gate, w_branch, w_o, ln1_g, ln1_b,
              w_up, conv_w, conv_b, w_down, ln2_g, ln2_b):
    B, S, _ = x.shape
    NM = mem.shape[1]
    split_points = np.cumsum(SEGMENTS)[:-1].tolist()
    h = layer_norm(x, ln_in_g, ln_in_b)
    for l in range(DEPTH):
        lambda_init = 0.8 - 0.6 * math.exp(-0.3 * l)
        proj = h @ w_in[l]
        dq, dk, dv, wq, wk, wv, mq = jnp.split(proj, split_points, axis=-1)
        a = diff_attention(dq.reshape(B, S, DIFF_HEADS, 2, DIFF_QK),
                           dk.reshape(B, S, DIFF_HEADS, 2, DIFF_QK),
                           dv.reshape(B, S, DIFF_HEADS, DIFF_V),
                           diff_lq1[l], diff_lk1[l], diff_lq2[l], diff_lk2[l], diff_subln_g[l],
                           rel_table, lambda_init)
        b = windowed_gqa(wq.reshape(B, S, WIN_HEADS, WIN_DIM),
                         wk.reshape(B, S, WIN_KV_HEADS, WIN_DIM),
                         wv.reshape(B, S, WIN_KV_HEADS, WIN_DIM),
                         win_sink[l], rel_table)
        mk, mv = jnp.split(mem @ w_mem_kv[l], 2, axis=-1)
        c = memory_attention(mq.reshape(B, S, MEM_HEADS, MEM_DIM),
                             mk.reshape(B, NM, MEM_HEADS, MEM_DIM),
                             mv.reshape(B, NM, MEM_HEADS, MEM_DIM))
        branches = jnp.stack([a, b, c], axis=2)
        widened = jnp.einsum('bsnc,ncd->bsnd', branches, w_branch[l])
        gates = jax.nn.sigmoid(h @ w_gate[l] + b_gate[l]).reshape(B, S, N_BRANCH, D_MODEL)
        mix = jnp.sum(gates * widened, axis=2) @ w_o[l]
        h = layer_norm(ALPHA * h + mix, ln1_g[l], ln1_b[l])
        ffn = conv_ffn(h, w_up[l], conv_w[l], conv_b[l], w_down[l])
        h = layer_norm(ALPHA * h + ffn, ln2_g[l], ln2_b[l])
    return h
```

```cpp
#include <hip/hip_runtime.h>
#include <cstdio>
#include <cstdint>
#include <cmath>
namespace pg8 {
#define PG8_LAS __attribute__((address_space(3)))
typedef unsigned short bf16_t;
typedef short bf16x8 __attribute__((ext_vector_type(8)));
typedef float f32x4 __attribute__((ext_vector_type(4)));
typedef float f32x2 __attribute__((ext_vector_type(2)));
typedef unsigned u32x4 __attribute__((ext_vector_type(4)));
typedef unsigned u32x2 __attribute__((ext_vector_type(2)));
constexpr int BM = 256, BK = 64, HALF = 128, HTB = HALF * BK * 2  , STAGE_BYTES = 8 * HTB, NXCD = 8, WGM = 8;

__host__ __device__ __forceinline__ int lds_byte(int r, int c) { const int st = (r >> 4) * 2 + (c >> 5), rr = r & 15, cc = c & 31, ob = rr * 64 + cc * 2; return st * 1024 + (ob ^ (((ob >> 9) & 1) << 5)); }
__host__ __device__ __forceinline__ void stage_rc(int b, int& R, int& C) { const int st = b / 1024, sb = b % 1024, swz = sb ^ (((sb >> 9) & 1) << 5); R = (st >> 1) * 16 + swz / 64; C = (st & 1) * 32 + (swz % 64) / 2; }
__host__ __device__ __forceinline__ int perm32(int rho) { const int n = rho >> 4, i = rho & 15; return 8 * (i >> 2) + 4 * n + (i & 3); }

struct Unit { int pm, pn, job; };
struct Gemm { const bf16_t* A; const bf16_t* Bt; int lda, ldb, M, N, K; };

struct StaticOrder {
    int nM, nN, nwg, G, c;
    __host__ __device__ void init(int M, int N, int G_, int c_) { nM = M / BM; nN = N / BM; nwg = nM * nN; G = G_; c = c_; }
    __host__ __device__ bool next(int i, Unit& u) const {
        const long L = (long)i * G + c; if (L >= nwg) return false;
        int wgid = (int)L; { const int q = nwg / NXCD, r = nwg % NXCD, xcd = wgid % NXCD, off = wgid / NXCD; wgid = (xcd < r ? xcd * (q + 1) : r * (q + 1) + (xcd - r) * q) + off; }
        const int nig = WGM * nN, gid = wgid / nig, fm = gid * WGM, gsz = (nM - fm) < WGM ? (nM - fm) : WGM;
        u.pm = fm + ((wgid % nig) % gsz); u.pn = (wgid % nig) / gsz; u.job = 0; return true;
    }
};
struct MultiOrder {
    int nM0, nN0, nM1, nN1, nM2, nN2, nM3, nN3, nM4, nN4, total, G, c;
    __host__ __device__ bool next(int i, Unit& u) const {
        const long L = (long)i * G + c; if (L >= total) return false;
        int wgid = (int)L; { const int q = total / NXCD, r = total % NXCD, xcd = wgid % NXCD, off = wgid / NXCD; wgid = (xcd < r ? xcd * (q + 1) : r * (q + 1) + (xcd - r) * q) + off; }
        int j = 0, m_ = nM0, n_ = nN0;
        if (wgid >= m_ * n_) { wgid -= m_ * n_; j = 1; m_ = nM1; n_ = nN1;
            if (wgid >= m_ * n_) { wgid -= m_ * n_; j = 2; m_ = nM2; n_ = nN2;
                if (wgid >= m_ * n_) { wgid -= m_ * n_; j = 3; m_ = nM3; n_ = nN3;
                    if (wgid >= m_ * n_) { wgid -= m_ * n_; j = 4; m_ = nM4; n_ = nN4; } } } }
        const int nig = WGM * n_, gid = wgid / nig, fm = gid * WGM, gsz = (m_ - fm) < WGM ? (m_ - fm) : WGM;
        u.pm = fm + ((wgid % nig) % gsz); u.pn = (wgid % nig) / gsz; u.job = j; return true;
    }
};

__device__ __forceinline__ unsigned cvt_pk_bf16(float lo, float hi) { unsigned r; asm volatile("v_cvt_pk_bf16_f32 %0, %1, %2" : "=v"(r) : "v"(lo), "v"(hi)); return r; }
__device__ __forceinline__ float bf_lo(unsigned w) { return __uint_as_float(w << 16); }
__device__ __forceinline__ float bf_hi(unsigned w) { return __uint_as_float(w & 0xffff0000u); }
__device__ __forceinline__ float sigmoidf_(float z) { return __builtin_amdgcn_rcpf(1.0f + __builtin_amdgcn_exp2f(-1.4426950408889634f * z)); }

struct EpiBf16 {
    static constexpr bool PERM = true;
    bf16_t* O; int ldc; const float* bias; int act;
    __device__ __forceinline__ void operator()(const f32x4 (&acc)[2][2][4][2], const Unit& u, int wr, int wc, int fr, int fq) const {
        const int row0 = u.pm * BM + wr * 64 + fr; const int col0 = u.pn * BM + wc * 32 + 8 * fq;
        f32x4 bv[2][2];
#pragma unroll
        for (int bj = 0; bj < 2; ++bj)
#pragma unroll
            for (int n = 0; n < 2; ++n) bv[bj][n] = bias ? *(const f32x4*)(bias + col0 + bj * HALF + 4 * n) : (f32x4){0.f, 0.f, 0.f, 0.f};
#pragma unroll
        for (int ai = 0; ai < 2; ++ai)
#pragma unroll
            for (int m = 0; m < 4; ++m) { bf16_t* rowp = O + (size_t)(row0 + ai * HALF + m * 16) * ldc + col0;
#pragma unroll
                for (int bj = 0; bj < 2; ++bj) { f32x4 v0 = acc[ai][bj][m][0] + bv[bj][0], v1 = acc[ai][bj][m][1] + bv[bj][1];
                    if (act == 2) {
#pragma unroll
                        for (int e = 0; e < 4; ++e) { v0[e] = sigmoidf_(v0[e]); v1[e] = sigmoidf_(v1[e]); } }
                    u32x4 w; w.x = cvt_pk_bf16(v0[0], v0[1]); w.y = cvt_pk_bf16(v0[2], v0[3]); w.z = cvt_pk_bf16(v1[0], v1[1]); w.w = cvt_pk_bf16(v1[2], v1[3]);
                    *(u32x4*)(rowp + bj * HALF) = w; } }
    }
};

struct EpiBf16Multi {
    static constexpr bool PERM = true;
    EpiBf16 e0, e1, e2, e3, e4;
    __device__ __forceinline__ void operator()(const f32x4 (&acc)[2][2][4][2], const Unit& u, int wr, int wc, int fr, int fq) const {
        const int j = u.job; EpiBf16 x;
        x.O = j == 1 ? e1.O : j == 2 ? e2.O : j == 3 ? e3.O : j == 4 ? e4.O : e0.O;
        x.ldc = j == 1 ? e1.ldc : j == 2 ? e2.ldc : j == 3 ? e3.ldc : j == 4 ? e4.ldc : e0.ldc;
        x.bias = j == 1 ? e1.bias : j == 2 ? e2.bias : j == 3 ? e3.bias : j == 4 ? e4.bias : e0.bias;
        x.act = j == 1 ? e1.act : j == 2 ? e2.act : j == 3 ? e3.act : j == 4 ? e4.act : e0.act;
        x(acc, u, wr, wc, fr, fq);
    }
};

struct EpiGate {
    static constexpr bool PERM = false;
    const bf16_t* G; int ldg; float* P; int ldp; bf16_t* O; int ldo; int mode;
    __device__ __forceinline__ void operator()(const f32x4 (&acc)[2][2][4][2], const Unit& u, int wr, int wc, int fr, int fq) const {
        const int row0 = u.pm * BM + wr * 64 + fr, col0 = u.pn * BM + wc * 32 + 4 * fq;
#pragma unroll
        for (int ai = 0; ai < 2; ++ai)
#pragma unroll
            for (int m = 0; m < 4; ++m) { const size_t row = (size_t)(row0 + ai * HALF + m * 16);
#pragma unroll
                for (int bj = 0; bj < 2; ++bj)
#pragma unroll
                    for (int n = 0; n < 2; ++n) { const int col = col0 + bj * HALF + n * 16;
                        const u32x2 gw = *(const u32x2*)(G + row * ldg + col);
                        f32x4 g; g[0] = bf_lo(gw.x); g[1] = bf_hi(gw.x); g[2] = bf_lo(gw.y); g[3] = bf_hi(gw.y);
                        f32x4 v = acc[ai][bj][m][n] * g;
                        if (mode != 0) v += *(const f32x4*)(P + row * ldp + col);
                        if (mode != 2) *(f32x4*)(P + row * ldp + col) = v;
                        else { u32x2 w; w.x = cvt_pk_bf16(v[0], v[1]); w.y = cvt_pk_bf16(v[2], v[3]); *(u32x2*)(O + row * ldo + col) = w; } } }
    }
};

struct EpiResid {
    static constexpr bool PERM = false;
    float* C; int ldc; float alpha;
    __device__ __forceinline__ void operator()(const f32x4 (&acc)[2][2][4][2], const Unit& u, int wr, int wc, int fr, int fq) const {
        const int row0 = u.pm * BM + wr * 64 + fr, col0 = u.pn * BM + wc * 32 + 4 * fq;
#pragma unroll
        for (int ai = 0; ai < 2; ++ai)
#pragma unroll
            for (int m = 0; m < 4; ++m) { float* rowp = C + (size_t)(row0 + ai * HALF + m * 16) * ldc + col0;
#pragma unroll
                for (int bj = 0; bj < 2; ++bj)
#pragma unroll
                    for (int n = 0; n < 2; ++n) { f32x4* p = (f32x4*)(rowp + bj * HALF + n * 16); *p = *p * alpha + acc[ai][bj][m][n]; } }
    }
};

struct SinglePtrs { const bf16_t* A; const bf16_t* Bt;
    __device__ __forceinline__ void bases(const Unit& u, size_t tA, size_t tB, const char*& a, const char*& b) const { a = (const char*)A + (size_t)u.pm * tA; b = (const char*)Bt + (size_t)u.pn * tB; } };
struct MultiPtrs { const bf16_t *A0, *B0, *A1, *B1, *A2, *B2, *A3, *B3, *A4, *B4;
    __device__ __forceinline__ void bases(const Unit& u, size_t tA, size_t tB, const char*& a, const char*& b) const {
        const int j = u.job;
        const bf16_t* pa = j == 1 ? A1 : j == 2 ? A2 : j == 3 ? A3 : j == 4 ? A4 : A0;
        const bf16_t* pb = j == 1 ? B1 : j == 2 ? B2 : j == 3 ? B3 : j == 4 ? B4 : B0;
        a = (const char*)pa + (size_t)u.pm * tA; b = (const char*)pb + (size_t)u.pn * tB; } };

template <class Epi, class Sched, class Ptrs, bool ALIGN_EPI = true>
__device__ __forceinline__ void gemm_phase(PG8_LAS unsigned char* lds, const Gemm g, const Sched& S, const Ptrs& P, const Epi& E) {
    const int tid = threadIdx.x, wid = __builtin_amdgcn_readfirstlane(tid >> 6), lane = tid & 63, wr = wid >> 2, wc = wid & 3, fr = lane & 15, fq = lane >> 4;
    const int K = g.K, nt = K / BK;
    unsigned voffA[2], voffB[2];
#pragma unroll
    for (int i = 0; i < 2; ++i) { int R, C; stage_rc(tid * 16 + i * 8192, R, C); const int Rb = Epi::PERM ? ((R & ~31) + perm32(R & 31)) : R;
        voffA[i] = (unsigned)(R * g.lda + C) * 2u; voffB[i] = (unsigned)(Rb * g.ldb + C) * 2u; }
    const size_t kstep = (size_t)(BK * 2);
    const size_t hA = (size_t)HALF * g.lda * 2, hB = (size_t)HALF * g.ldb * 2;
    const size_t tA = 2 * hA, tB = 2 * hB;
    const unsigned ldsw = (unsigned)wid * 1024u;
    const int aoff = lds_byte(wr * 64 + fr, fq * 8), boff = lds_byte(wc * 32 + fr, fq * 8);
#define PG8_SA(b, h) (((b) * 2 + (h)) * HTB)
#define PG8_SB(b, h) ((4 + (b) * 2 + (h)) * HTB)
#define PG8_STAGE(bufoff, gbase, voff) do { _Pragma("unroll") for (int _i = 0; _i < 2; ++_i) \
        __builtin_amdgcn_global_load_lds((const unsigned*)((const char*)(gbase) + (voff)[_i]), (PG8_LAS unsigned*)(lds + (bufoff) + ldsw + _i * 8192), 16, 0, 0); } while (0)
#define PG8_LDA(dst, b, h) do { _Pragma("unroll") for (int m = 0; m < 4; ++m) _Pragma("unroll") for (int k = 0; k < 2; ++k) dst[m][k] = *(const PG8_LAS bf16x8*)(lds + PG8_SA(b, h) + aoff + m * 2048 + k * 1024); } while (0)
#define PG8_LDB(dst, b, h) do { _Pragma("unroll") for (int n = 0; n < 2; ++n) _Pragma("unroll") for (int k = 0; k < 2; ++k) dst[n][k] = *(const PG8_LAS bf16x8*)(lds + PG8_SB(b, h) + boff + n * 2048 + k * 1024); } while (0)
#define PG8_MMA(ai, bj, At, Bt) do { __builtin_amdgcn_s_setprio(1); _Pragma("unroll") for (int m = 0; m < 4; ++m) _Pragma("unroll") for (int n = 0; n < 2; ++n) _Pragma("unroll") for (int k = 0; k < 2; ++k) \
        acc[ai][bj][m][n] = __builtin_amdgcn_mfma_f32_16x16x32_bf16(Bt[n][k], At[m][k], acc[ai][bj][m][n], 0, 0, 0); __builtin_amdgcn_s_setprio(0); } while (0)
#define PG8_WAIT_V(n) asm volatile("s_waitcnt vmcnt(" #n ")" ::: "memory")
#define PG8_WAIT_L(n) asm volatile("s_waitcnt lgkmcnt(" #n ")" ::: "memory")
#define PG8_BAR __builtin_amdgcn_s_barrier()
#define PG8_SCHED __builtin_amdgcn_sched_barrier(0)
    Unit cur, nxt; int ui = 0;
    if (!S.next(0, cur)) return;
    f32x4 acc[2][2][4][2];
#pragma unroll
    for (int a = 0; a < 2; ++a)
#pragma unroll
        for (int b = 0; b < 2; ++b)
#pragma unroll
            for (int m = 0; m < 4; ++m)
#pragma unroll
                for (int n = 0; n < 2; ++n) acc[a][b][m][n] = (f32x4){0.f, 0.f, 0.f, 0.f};
    bf16x8 At[4][2], B0[2][2], B1[2][2];
    const char* cA; const char* cB; P.bases(cur, tA, tB, cA, cB);
    PG8_STAGE(PG8_SB(0, 0), cB, voffB); PG8_STAGE(PG8_SB(0, 1), cB + hB, voffB); PG8_STAGE(PG8_SA(0, 0), cA, voffA); PG8_STAGE(PG8_SA(0, 1), cA + hA, voffA);
    if (wr == 1) PG8_BAR;
    PG8_WAIT_V(2); PG8_BAR;
    PG8_STAGE(PG8_SB(1, 0), cB + kstep, voffB); PG8_STAGE(PG8_SA(1, 0), cA + kstep, voffA); PG8_STAGE(PG8_SB(1, 1), cB + hB + kstep, voffB);
    PG8_WAIT_V(6); PG8_BAR;
    for (;;) {
        const bool has_next = S.next(ui + 1, nxt);
        const char* nA = cA; const char* nB = cB; if (has_next) P.bases(nxt, tA, tB, nA, nB);
        for (int t = 0; t < nt; t += 2) {
            const bool last = (t == nt - 2);
            const char* a1 = cA + (size_t)(t + 1) * kstep;
            const char* a2 = last ? nA : cA + (size_t)(t + 2) * kstep; const char* b2 = last ? nB : cB + (size_t)(t + 2) * kstep;
            const char* a3 = a2 + kstep; const char* b3 = b2 + kstep;
            PG8_LDB(B0, 0, 0); PG8_LDB(B1, 0, 1); PG8_SCHED; PG8_LDA(At, 0, 0); PG8_STAGE(PG8_SA(1, 1), a1 + hA, voffA);
            PG8_WAIT_V(8); PG8_WAIT_L(0); PG8_BAR; PG8_MMA(0, 0, At, B0); PG8_MMA(0, 1, At, B1); PG8_BAR; PG8_SCHED;
            PG8_LDA(At, 0, 1); PG8_STAGE(PG8_SB(0, 0), b2, voffB); PG8_STAGE(PG8_SB(0, 1), b2 + hB, voffB); PG8_STAGE(PG8_SA(0, 0), a2, voffA);
            PG8_WAIT_V(8); PG8_WAIT_L(0); PG8_BAR; PG8_MMA(1, 0, At, B0); PG8_MMA(1, 1, At, B1); PG8_BAR; PG8_SCHED;
            PG8_LDB(B0, 1, 0); PG8_LDB(B1, 1, 1); PG8_SCHED; PG8_LDA(At, 1, 0); PG8_STAGE(PG8_SA(0, 1), a2 + hA, voffA);
            PG8_WAIT_V(8); PG8_WAIT_L(0); PG8_BAR; PG8_MMA(0, 0, At, B0); PG8_MMA(0, 1, At, B1); PG8_BAR; PG8_SCHED;
            PG8_LDA(At, 1, 1); PG8_STAGE(PG8_SB(1, 0), b3, voffB); PG8_STAGE(PG8_SB(1, 1), b3 + hB, voffB); PG8_STAGE(PG8_SA(1, 0), a3, voffA);
            PG8_WAIT_V(8); PG8_WAIT_L(0); PG8_BAR; PG8_MMA(1, 0, At, B0); PG8_MMA(1, 1, At, B1); PG8_BAR; PG8_SCHED;
        }
        if constexpr (ALIGN_EPI) { if (wr == 0) PG8_BAR; }
        E(acc, cur, wr, wc, fr, fq);
        if (!has_next) break;
#pragma unroll
        for (int a = 0; a < 2; ++a)
#pragma unroll
            for (int b = 0; b < 2; ++b)
#pragma unroll
                for (int m = 0; m < 4; ++m)
#pragma unroll
                    for (int n = 0; n < 2; ++n) acc[a][b][m][n] = (f32x4){0.f, 0.f, 0.f, 0.f};
        cur = nxt; cA = nA; cB = nB; ++ui;
        if constexpr (ALIGN_EPI) { if (wr == 1) PG8_BAR; }
    }
    PG8_WAIT_V(0);
    if constexpr (!ALIGN_EPI) { if (wr == 0) PG8_BAR; }
    PG8_BAR;
#undef PG8_SA
#undef PG8_SB
#undef PG8_STAGE
#undef PG8_LDA
#undef PG8_LDB
#undef PG8_MMA
#undef PG8_WAIT_V
#undef PG8_WAIT_L
#undef PG8_BAR
#undef PG8_SCHED
}
}
namespace att {
#define ATT_LAS __attribute__((address_space(3)))
typedef unsigned short bf16_t;
typedef short bf16x8 __attribute__((ext_vector_type(8)));
typedef short s16x4 __attribute__((ext_vector_type(4)));
typedef float f32x16 __attribute__((ext_vector_type(16)));
typedef unsigned u32x4 __attribute__((ext_vector_type(4)));
typedef unsigned u32x2 __attribute__((ext_vector_type(2)));
constexpr float LOG2E = 1.4426950408889634f;
constexpr float NEGBIG = -1e30f;
constexpr int VROW = 136;
constexpr int BIAS_OFF = 60 * 1024;
constexpr int BIAS_STRIDE = 1040;

__device__ __forceinline__ unsigned pk_bf16(float lo, float hi) { unsigned r; asm volatile("v_cvt_pk_bf16_f32 %0, %1, %2" : "=v"(r) : "v"(lo), "v"(hi)); return r; }

__device__ __forceinline__ int t5_bucket(int rel) {
    const int n = rel < 0 ? -rel : rel; const int ret = rel > 0 ? 16 : 0;
    const float nf = (float)(n < 1 ? 1 : n);
    int large = 8 + (int)(logf(nf / 8.0f) / 2.7725887222397811f * 8.0f);
    large = large < 15 ? large : 15;
    return ret + (n < 8 ? n : large);
}
__device__ __forceinline__ void fill_bias(ATT_LAS unsigned char* lds, int t, const float* rel_table, int col) {
    ATT_LAS float* tab = (ATT_LAS float*)(lds + BIAS_OFF + t * BIAS_STRIDE);
    for (int i = threadIdx.x; i < 257; i += 512) tab[i] = rel_table[t5_bucket(i - 128) * 16 + col] * LOG2E;
}

struct Desc {
    const bf16_t* Qw; int ldq;
    const bf16_t* K;  int ldk;
    const bf16_t* Vt; int ldv;
    bf16_t* Ow; int ldo;
    int qpos0;
    int kt0, kt1;
    int btab;
    float sc2;
    float sink2;
    float lam;
    const float* subg;
};

template <int NMAP, int DQK, bool BIAS, bool WIN, bool SUBLN>
__device__ __forceinline__ void attn_unit(ATT_LAS unsigned char* lds, const Desc& D) {
    constexpr int DKT = NMAP * DQK, KROW = DKT * 2 + 16, CPR = DKT / 8, NKC = 64 * CPR / 512, NDC = DQK / 16;
    constexpr int LDS_K = 0, LDS_V = 64 * KROW;
    static_assert(LDS_V + 128 * VROW <= BIAS_OFF, "attention LDS map");
    const int tid = threadIdx.x, lane = tid & 63, r = lane & 31, h = lane >> 5;
    bf16x8 qf[NMAP][NDC];
#pragma unroll
    for (int c = 0; c < NMAP; ++c)
#pragma unroll
        for (int dc = 0; dc < NDC; ++dc) qf[c][dc] = *(const bf16x8*)(D.Qw + (size_t)r * D.ldq + c * DQK + 16 * dc + 8 * h);
    const ATT_LAS float* tab = (const ATT_LAS float*)(lds + BIAS_OFF + D.btab * BIAS_STRIDE);
    const int qpos = D.qpos0 + r;
    u32x4 kreg[NKC], vreg[2];
#define ATT_LOADK(kt) do { _Pragma("unroll") for (int i = 0; i < NKC; ++i) { const int c = tid + 512 * i, row = c / CPR, cc = c % CPR; \
        kreg[i] = *(const u32x4*)(D.K + (size_t)((kt) * 64 + row) * D.ldk + cc * 8); } } while (0)
#define ATT_STOREK() do { _Pragma("unroll") for (int i = 0; i < NKC; ++i) { const int c = tid + 512 * i, row = c / CPR, cc = c % CPR; \
        *(ATT_LAS u32x4*)(lds + LDS_K + row * KROW + cc * 16) = kreg[i]; } } while (0)
#define ATT_LOADV(kt) do { _Pragma("unroll") for (int i = 0; i < 2; ++i) { const int c = tid + 512 * i, row = c >> 3, cc = c & 7; \
        vreg[i] = *(const u32x4*)(D.Vt + (size_t)row * D.ldv + (kt) * 64 + cc * 8); } } while (0)
#define ATT_STOREV() do { _Pragma("unroll") for (int i = 0; i < 2; ++i) { const int c = tid + 512 * i, row = c >> 3, cc = c & 7; \
        ATT_LAS u32x2* p = (ATT_LAS u32x2*)(lds + LDS_V + row * VROW + cc * 16); p[0] = (u32x2){vreg[i].x, vreg[i].y}; p[1] = (u32x2){vreg[i].z, vreg[i].w}; } } while (0)
#define ATT_SCORES(kt, hh) do { \
        _Pragma("unroll") for (int c = 0; c < NMAP; ++c) { f32x16 a = {}; \
            _Pragma("unroll") for (int dc = 0; dc < NDC; ++dc) { const bf16x8 kf = *(const ATT_LAS bf16x8*)(lds + LDS_K + (32 * (hh) + r) * KROW + (c * DQK + 16 * dc + 8 * h) * 2); \
                a = __builtin_amdgcn_mfma_f32_32x32x16_bf16(kf, qf[c][dc], a, 0, 0, 0); } \
            s[c] = a; } \
        _Pragma("unroll") for (int i = 0; i < 16; ++i) { \
            const int rel = (kt) * 64 + 32 * (hh) + (i & 3) + 8 * (i >> 2) + 4 * h - qpos; float b = 0.f; \
            if (BIAS) { int ix = rel < -128 ? -128 : (rel > 128 ? 128 : rel); b = tab[ix + 128]; } \
            const bool ok = !WIN || (rel >= -128 && rel <= 128); \
            _Pragma("unroll") for (int c = 0; c < NMAP; ++c) { const float v = s[c][i] * D.sc2 + b; s[c][i] = ok ? v : NEGBIG; } } } while (0)
    const bool wave_all = !WIN;
#define ATT_ACTIVE(kt) (wave_all || ((kt) * 64 + 63 >= D.qpos0 - 128 && (kt) * 64 <= D.qpos0 + 31 + 128))

    float m[NMAP], l[NMAP];
#pragma unroll
    for (int c = 0; c < NMAP; ++c) { m[c] = (WIN && h == 0) ? D.sink2 : NEGBIG; l[c] = (WIN && h == 0) ? 1.f : 0.f; }
    f32x16 s[NMAP];
    ATT_LOADK(D.kt0);
    for (int kt = D.kt0; kt < D.kt1; ++kt) {
        ATT_STOREK(); __syncthreads();
        if (kt + 1 < D.kt1) ATT_LOADK(kt + 1);
        if (ATT_ACTIVE(kt)) {
#pragma unroll
            for (int hh = 0; hh < 2; ++hh) {
                ATT_SCORES(kt, hh);
#pragma unroll
                for (int c = 0; c < NMAP; ++c) {
                    float tm = s[c][0];
#pragma unroll
                    for (int i = 1; i < 16; ++i) tm = fmaxf(tm, s[c][i]);
                    const float mn = fmaxf(m[c], tm); float sum = 0.f;
#pragma unroll
                    for (int i = 0; i < 16; ++i) sum += __builtin_amdgcn_exp2f(s[c][i] - mn);
                    l[c] = l[c] * __builtin_amdgcn_exp2f(m[c] - mn) + sum; m[c] = mn;
                }
            }
        }
        __syncthreads();
    }
    float coef[NMAP];
#pragma unroll
    for (int c = 0; c < NMAP; ++c) {
        const float mo = __shfl_xor(m[c], 32), lo = __shfl_xor(l[c], 32); const float M = fmaxf(m[c], mo);
        const float L = l[c] * __builtin_amdgcn_exp2f(m[c] - M) + lo * __builtin_amdgcn_exp2f(mo - M);
        m[c] = M; coef[c] = 1.0f / L;
    }
    if (NMAP == 2) coef[NMAP - 1] = -D.lam * coef[NMAP - 1];
    f32x16 o[4];
#pragma unroll
    for (int db = 0; db < 4; ++db) o[db] = (f32x16){};
    ATT_LOADK(D.kt0); ATT_LOADV(D.kt0);
    for (int kt = D.kt0; kt < D.kt1; ++kt) {
        ATT_STOREK(); ATT_STOREV(); __syncthreads();
        if (kt + 1 < D.kt1) { ATT_LOADK(kt + 1); ATT_LOADV(kt + 1); }
        if (ATT_ACTIVE(kt)) {
#pragma unroll
            for (int hh = 0; hh < 2; ++hh) {
                ATT_SCORES(kt, hh);
                float p[16];
#pragma unroll
                for (int i = 0; i < 16; ++i) { float a = 0.f;
#pragma unroll
                    for (int c = 0; c < NMAP; ++c) a += __builtin_amdgcn_exp2f(s[c][i] - m[c]) * coef[c];
                    p[i] = a; }
#pragma unroll
                for (int ks = 0; ks < 2; ++ks) {
                    u32x4 pw; pw.x = pk_bf16(p[8 * ks + 0], p[8 * ks + 1]); pw.y = pk_bf16(p[8 * ks + 2], p[8 * ks + 3]); pw.z = pk_bf16(p[8 * ks + 4], p[8 * ks + 5]); pw.w = pk_bf16(p[8 * ks + 6], p[8 * ks + 7]);
                    const bf16x8 pf = __builtin_bit_cast(bf16x8, pw);
#pragma unroll
                    for (int db = 0; db < 4; ++db) {
                        const ATT_LAS u32x2* vp = (const ATT_LAS u32x2*)(lds + LDS_V + (32 * db + r) * VROW + (32 * hh + 16 * ks + 4 * h) * 2);
                        const u32x2 v0 = vp[0], v1 = vp[2];
                        const bf16x8 vf = __builtin_bit_cast(bf16x8, (u32x4){v0.x, v0.y, v1.x, v1.y});
                        o[db] = __builtin_amdgcn_mfma_f32_32x32x16_bf16(pf, vf, o[db], 0, 0, 0);
                    }
                }
            }
        }
        __syncthreads();
    }
    if (SUBLN) {
        float gain[4];
#pragma unroll
        for (int db = 0; db < 4; ++db) gain[db] = D.subg[32 * db + r] * 0.8f;
#pragma unroll
        for (int i = 0; i < 16; ++i) {
            float ss = 0.f;
#pragma unroll
            for (int db = 0; db < 4; ++db) ss += o[db][i] * o[db][i];
            ss += __shfl_xor(ss, 1); ss += __shfl_xor(ss, 2); ss += __shfl_xor(ss, 4); ss += __shfl_xor(ss, 8); ss += __shfl_xor(ss, 16);
            const float rs = 1.0f / sqrtf(ss * (1.0f / 128.0f) + 1e-5f);
#pragma unroll
            for (int db = 0; db < 4; ++db) o[db][i] = o[db][i] * rs * gain[db];
        }
    }
#pragma unroll
    for (int i = 0; i < 16; ++i) { const int q = (i & 3) + 8 * (i >> 2) + 4 * h; bf16_t* orow = D.Ow + (size_t)q * D.ldo + r;
#pragma unroll
        for (int db = 0; db < 4; ++db) orow[32 * db] = (bf16_t)(pk_bf16(o[db][i], 0.f) & 0xffffu); }
#undef ATT_LOADK
#undef ATT_STOREK
#undef ATT_LOADV
#undef ATT_STOREV
#undef ATT_SCORES
#undef ATT_ACTIVE
}
}
constexpr int NWAVES = 8;
#ifndef MK_N_LAUNCHES
#define MK_N_LAUNCHES 1
#endif
constexpr int N_PHASES = 10;
constexpr int N_LAUNCHES = MK_N_LAUNCHES;

constexpr int BATCH = 4, SEQ = 2048, D = 2048, T = BATCH * SEQ, NMEM = 256, TM = BATCH * NMEM;
constexpr int IN_W = 5632, NQK = 4352, NV = 1280, NG = 6144, DFF = 5504, NUP = 2 * DFF, NBR = 3072;
constexpr float LN_EPS = 1e-5f;
constexpr float ALPHA = 1.189207115002721f;
constexpr int C_DQ = 0, C_DK = 1024, C_WQ = 2048, C_WK = 3072, C_MQ = 3328;

constexpr size_t MiB = 1u << 20;
constexpr size_t WS_CTL = 0, CTL_ZERO_BYTES = 64 * 1024;
constexpr size_t WS_WBR = 1 * MiB;
constexpr size_t WS_WO = 13 * MiB;
constexpr size_t WS_WINQK = 21 * MiB;
constexpr size_t WS_WINV = 38 * MiB;
constexpr size_t WS_WGATE = 43 * MiB;
constexpr size_t WS_WMEM = 67 * MiB;
constexpr size_t WS_H0B = 75 * MiB;
constexpr size_t WS_MEMB = 107 * MiB;
constexpr size_t WS_QKP = 111 * MiB;
constexpr size_t WS_VT = 179 * MiB;
constexpr size_t WS_MK = 199 * MiB;
constexpr size_t WS_MVT = 201 * MiB;
constexpr size_t WS_GATES = 203 * MiB;
constexpr size_t WS_BR = 299 * MiB;
constexpr size_t WS_PART = 111 * MiB;
constexpr size_t WS_MIXED = 21 * MiB;
constexpr size_t WS_H1B = 53 * MiB;
constexpr size_t WS_WUP = 111 * MiB;
constexpr size_t WS_WDOWN = 154 * MiB;
constexpr size_t WS_U = 176 * MiB;
constexpr size_t WS_ACT = 21 * MiB;
constexpr size_t WS_END = 348 * MiB;
constexpr int CW_BAR = 1024;

constexpr int RING_BYTES = 131072, LDSCTL_OFF = RING_BYTES, MISC_OFF = LDSCTL_OFF + 320, LDS_BYTES = 147456;

#define GAS __attribute__((address_space(1)))
#define LAS __attribute__((address_space(3)))
typedef unsigned short bf16;
typedef unsigned v4u __attribute__((ext_vector_type(4)));
typedef unsigned v2u __attribute__((ext_vector_type(2)));
typedef float f32x4 __attribute__((ext_vector_type(4)));
#define LDS_WAIT() asm volatile("s_waitcnt lgkmcnt(0)" ::: "memory")
__device__ __forceinline__ unsigned f2bf(float f) { unsigned u = __builtin_bit_cast(unsigned, f); return (u + 0x7fffu + ((u >> 16) & 1u)) >> 16; }
__device__ __forceinline__ unsigned pk2(float lo, float hi) { return f2bf(lo) | (f2bf(hi) << 16); }
__device__ __forceinline__ float bflo(unsigned w) { return __uint_as_float(w << 16); }
__device__ __forceinline__ float bfhi(unsigned w) { return __uint_as_float(w & 0xffff0000u); }

#define XB_TMO      128
#define XB_XCNT(j)  (256  + 64 * (j))
#define XB_XSUB(j)  (1280 + 64 * (j))
#define XB_XGEN(j)  (2304 + 64 * (j))
#define XB_TOP      3328
#define XB_TOPGEN   3392
#define XCD_BAR_WORDS 3456
#define XB_SPIN_CAP (1u << 20)
__device__ __forceinline__ unsigned xb_ld(unsigned* p)              { return __hip_atomic_load(p, __ATOMIC_RELAXED, __HIP_MEMORY_SCOPE_AGENT); }
__device__ __forceinline__ unsigned xb_add(unsigned* p, unsigned v) { return __hip_atomic_fetch_add(p, v, __ATOMIC_RELAXED, __HIP_MEMORY_SCOPE_AGENT); }
__device__ __forceinline__ unsigned xb_xcc_id() { return (unsigned)__builtin_amdgcn_s_getreg((3 << 11) | 20) & 0xFu; }
#define XB_SPIN(cond, bar) do { unsigned _sp = 0; while (cond) { __builtin_amdgcn_s_sleep(1); \
    if ((++_sp & 255u) == 0u) { if (xb_ld(&(bar)[XB_TMO])) break; if (_sp > XB_SPIN_CAP) { atomicAdd(&(bar)[XB_TMO], 1u); break; } } } } while (0)
struct XcdBarrier { unsigned* bar; unsigned x; volatile LAS unsigned* st; };
__device__ __forceinline__ XcdBarrier xcd_barrier_post(unsigned* bar, volatile LAS unsigned* st) {
    XcdBarrier b; b.bar = bar; b.x = xb_xcc_id(); b.st = st;
    if (threadIdx.x == 0) (void)xb_add(&bar[XB_XCNT(b.x)], 1u);
    return b;
}
__device__ __forceinline__ void xcd_barrier_complete(unsigned* bar, unsigned x, unsigned& nloc, unsigned& nx) {
    const unsigned G = gridDim.x * gridDim.y * gridDim.z;
    unsigned sum, cnt, mine, sp = 0u;
    for (;;) {
        sum = 0u; cnt = 0u; mine = 0u;
#pragma unroll
        for (unsigned j = 0; j < 16; ++j) { const unsigned c = xb_ld(&bar[XB_XCNT(j)]); sum += c; cnt += (c > 0u) ? 1u : 0u; mine = (j == x) ? c : mine; }
        if (sum == G) break;
        __builtin_amdgcn_s_sleep(1);
        if ((++sp & 255u) == 0u) { if (xb_ld(&bar[XB_TMO])) break; if (sp > XB_SPIN_CAP) { atomicAdd(&bar[XB_TMO], 1u); break; } }
    }
    nloc = mine > 0u ? mine : 1u; nx = cnt > 0u ? cnt : 1u;
}
__device__ __forceinline__ void xcd_barrier(const XcdBarrier& b) {
    asm volatile("s_waitcnt vmcnt(0)" ::: "memory");
    __syncthreads();
    if (threadIdx.x == 0) {
        unsigned* bar = b.bar;
        __builtin_amdgcn_s_waitcnt(0);
        unsigned nloc = b.st[0], nx = b.st[1];
        if (nloc == 0u) { xcd_barrier_complete(bar, b.x, nloc, nx); b.st[0] = nloc; b.st[1] = nx; }
        const unsigned old = xb_add(&bar[XB_XSUB(b.x)], 1u);
        const unsigned gen = old / nloc;
        if (old + 1u == (gen + 1u) * nloc) {
            __builtin_amdgcn_fence(__ATOMIC_RELEASE, "agent");
            asm volatile("s_waitcnt vmcnt(0)" ::: "memory");
            const unsigned og = xb_add(&bar[XB_TOP], 1u);
            const unsigned tg = og / nx;
            if (og + 1u == (tg + 1u) * nx) xb_add(&bar[XB_TOPGEN], 1u);
            else XB_SPIN(xb_ld(&bar[XB_TOPGEN]) == tg, bar);
            __builtin_amdgcn_fence(__ATOMIC_ACQUIRE, "agent");
            xb_add(&bar[XB_XGEN(b.x)], 1u);
            asm volatile("s_waitcnt vmcnt(0)" ::: "memory");
        } else {
            XB_SPIN(xb_ld(&bar[XB_XGEN(b.x)]) == gen, bar);
            __builtin_amdgcn_fence(__ATOMIC_ACQUIRE, "agent");
            asm volatile("s_waitcnt vmcnt(0)" ::: "memory");
        }
    }
    __syncthreads();
}

__device__ __forceinline__ float wave_sum(float v) {
#pragma unroll
    for (int o = 1; o < 64; o <<= 1) v += __shfl_xor(v, o);
    return v;
}
__device__ __forceinline__ void transpose_item(const float* W, int ldw, int K, int ncols, bf16* WT, int item, int lane) {
    const int nblk = ncols / 64, kb = item / nblk, nb = item % nblk, k0 = 64 * kb + 16 * (lane >> 4), n0 = 64 * nb + 4 * (lane & 15);
    const GAS float* src = (const GAS float*)W + (size_t)k0 * ldw + n0;
    f32x4 v[16];
#pragma unroll
    for (int i = 0; i < 16; ++i) v[i] = *(const GAS f32x4*)(src + (size_t)i * ldw);
#pragma unroll
    for (int j = 0; j < 4; ++j) {
        GAS v4u* dst = (GAS v4u*)(WT + (size_t)(n0 + j) * K + k0);
        v4u o0, o1;
        o0.x = pk2(v[0][j], v[1][j]); o0.y = pk2(v[2][j], v[3][j]); o0.z = pk2(v[4][j], v[5][j]); o0.w = pk2(v[6][j], v[7][j]);
        o1.x = pk2(v[8][j], v[9][j]); o1.y = pk2(v[10][j], v[11][j]); o1.z = pk2(v[12][j], v[13][j]); o1.w = pk2(v[14][j], v[15][j]);
        dst[0] = o0; dst[1] = o1;
    }
}
__device__ __forceinline__ void ln_row(const float* xrow, const float* g, const float* b, float* orow, bf16* brow, int lane) {
    const GAS f32x4* xr = (const GAS f32x4*)xrow + lane;
    f32x4 v[8]; float s = 0.f;
#pragma unroll
    for (int j = 0; j < 8; ++j) { v[j] = xr[64 * j]; s += (v[j].x + v[j].y) + (v[j].z + v[j].w); }
    const float mean = wave_sum(s) * (1.f / D); float s2 = 0.f;
#pragma unroll
    for (int j = 0; j < 8; ++j) { v[j] = v[j] - mean; s2 += (v[j].x * v[j].x + v[j].y * v[j].y) + (v[j].z * v[j].z + v[j].w * v[j].w); }
    const float rstd = 1.f / sqrtf(wave_sum(s2) * (1.f / D) + LN_EPS);
#pragma unroll
    for (int j = 0; j < 8; ++j) {
        const f32x4 gg = ((const GAS f32x4*)g)[lane + 64 * j], bb = ((const GAS f32x4*)b)[lane + 64 * j];
        const f32x4 y = v[j] * rstd * gg + bb;
        if (orow) ((GAS f32x4*)orow)[lane + 64 * j] = y;
        if (brow) ((GAS v2u*)brow)[lane + 64 * j] = (v2u){pk2(y.x, y.y), pk2(y.z, y.w)};
    }
}
__device__ __forceinline__ float gelu_tanh(float x) {
    const float z = 1.5957691216057308f * (x + 0.044715f * x * x * x);
    return x * __builtin_amdgcn_rcpf(1.0f + __builtin_amdgcn_exp2f(-1.4426950408889634f * z));
}
struct Args { const float* in[25]; float* out; unsigned char* ws; int ph_lo, ph_hi; };
enum { I_X = 0, I_MEM, I_LNG, I_LNB, I_REL, I_WIN, I_WMEM, I_LQ1, I_LK1, I_LQ2, I_LK2, I_SUBG, I_SINK, I_WGATE, I_BGATE, I_WBR, I_WO, I_LN1G, I_LN1B, I_WUP, I_CONVW, I_CONVB, I_WDOWN, I_LN2G, I_LN2B };

__device__ __forceinline__ void phase_attention(LAS unsigned char* lds, const Args& args, const bf16* QKP, const bf16* VT, const bf16* MK, const bf16* MVT, bf16* BR, int vcu, int G, int wave, int lane) {
        const float* rel_table = args.in[I_REL];
        float lam;
        { const float s1 = wave_sum(args.in[I_LQ1][lane] * args.in[I_LK1][lane]), s2 = wave_sum(args.in[I_LQ2][lane] * args.in[I_LK2][lane]); lam = expf(s1) - expf(s2) + 0.2f; }
        for (int u = vcu; u < 256; u += G) {
            const int b = u >> 6, h = (u >> 3) & 7, qb = u & 7;
            att::fill_bias(lds, 0, rel_table, h); __syncthreads();
            att::Desc d; const size_t row0 = (size_t)b * SEQ + qb * 256 + wave * 32;
            d.Qw = QKP + row0 * NQK + C_DQ + h * 128; d.ldq = NQK; d.K = QKP + (size_t)b * SEQ * NQK + C_DK + h * 128; d.ldk = NQK;
            d.Vt = VT + (size_t)(h * 128) * T + (size_t)b * SEQ; d.ldv = T; d.Ow = BR + row0 * NBR + h * 128; d.ldo = NBR;
            d.qpos0 = qb * 256 + wave * 32; d.kt0 = 0; d.kt1 = SEQ / 64; d.btab = 0; d.sc2 = 0.125f * att::LOG2E; d.sink2 = 0.f; d.lam = lam; d.subg = args.in[I_SUBG];
            att::attn_unit<2, 64, true, false, true>(lds, d);
        }
        for (int u = vcu; u < 256; u += G) {
            const int b = u >> 6, kvh = (u >> 5) & 1, qb = (u >> 1) & 15, pair = u & 1; const int qh = kvh * 4 + pair * 2 + (wave >> 2), qsub = wave & 3;
            att::fill_bias(lds, 0, rel_table, 8 + kvh * 4 + pair * 2); att::fill_bias(lds, 1, rel_table, 8 + kvh * 4 + pair * 2 + 1); __syncthreads();
            att::Desc d; const size_t row0 = (size_t)b * SEQ + qb * 128 + qsub * 32;
            d.Qw = QKP + row0 * NQK + C_WQ + qh * 128; d.ldq = NQK; d.K = QKP + (size_t)b * SEQ * NQK + C_WK + kvh * 128; d.ldk = NQK;
            d.Vt = VT + (size_t)(1024 + kvh * 128) * T + (size_t)b * SEQ; d.ldv = T; d.Ow = BR + row0 * NBR + 1024 + qh * 128; d.ldo = NBR;
            d.qpos0 = qb * 128 + qsub * 32; d.kt0 = (2 * qb - 2) < 0 ? 0 : (2 * qb - 2); d.kt1 = (2 * qb + 4) > SEQ / 64 ? SEQ / 64 : (2 * qb + 4);
            d.btab = wave >> 2; d.sc2 = 0.08838834764831845f * att::LOG2E; d.sink2 = args.in[I_SINK][qh] * att::LOG2E; d.lam = 0.f; d.subg = nullptr;
            att::attn_unit<1, 128, true, true, false>(lds, d);
        }
        for (int u = vcu; u < 256; u += G) {
            const int b = u >> 6, h = (u >> 4) & 3, qb = (u >> 1) & 7, half = u & 1;
            att::Desc d; const size_t row0 = (size_t)b * SEQ + qb * 256 + wave * 32;
            d.Qw = QKP + row0 * NQK + C_MQ + h * 256; d.ldq = NQK; d.K = MK + (size_t)(b * NMEM) * 1024 + h * 256; d.ldk = 1024;
            d.Vt = MVT + (size_t)(h * 256 + half * 128) * TM + b * NMEM; d.ldv = TM; d.Ow = BR + row0 * NBR + 2048 + h * 256 + half * 128; d.ldo = NBR;
            d.qpos0 = 0; d.kt0 = 0; d.kt1 = NMEM / 64; d.btab = 0; d.sc2 = 0.0625f * att::LOG2E; d.sink2 = 0.f; d.lam = 0.f; d.subg = nullptr;
            att::attn_unit<1, 256, false, false, false>(lds, d);
        }
}

__global__ void __launch_bounds__(NWAVES * 64, 2) mega_fwd(Args args) {
    extern __shared__ __attribute__((aligned(16))) unsigned char lds_raw[];
    LAS unsigned char* lds = (LAS unsigned char*)lds_raw;
    volatile LAS unsigned* MISC = (volatile LAS unsigned*)(lds + MISC_OFF);
    const int tid = threadIdx.x, lane = tid & 63, wave = __builtin_amdgcn_readfirstlane(tid >> 6);
    const int G = gridDim.x, bx = blockIdx.x;
    const int vcu = (G % 8 == 0) ? (bx % 8) * (G / 8) + bx / 8 : bx;
    unsigned char* ws = args.ws;
    for (int u = tid; u < (LDS_BYTES - LDSCTL_OFF) / 4; u += NWAVES * 64) ((LAS unsigned*)(lds + LDSCTL_OFF))[u] = 0u;
    __syncthreads();
    XcdBarrier bar; bar.bar = (unsigned*)(ws + WS_CTL) + CW_BAR; bar.x = 0; bar.st = nullptr;
    if (N_LAUNCHES == 1) bar = xcd_barrier_post((unsigned*)(ws + WS_CTL) + CW_BAR, MISC + 8);
#define GRID_BAR() do { if (N_LAUNCHES == 1) xcd_barrier(bar); } while (0)
    const int lo = args.ph_lo, hi = args.ph_hi;
#define IN(k) (lo <= (k) && (k) < hi)
    float* out = args.out;
    bf16* const Wbr_t = (bf16*)(ws + WS_WBR); bf16* const Wo_t = (bf16*)(ws + WS_WO); bf16* const WinQK_t = (bf16*)(ws + WS_WINQK); bf16* const WinV_t = (bf16*)(ws + WS_WINV);
    bf16* const Wgate_t = (bf16*)(ws + WS_WGATE); bf16* const Wmem_t = (bf16*)(ws + WS_WMEM); bf16* const H0b = (bf16*)(ws + WS_H0B); bf16* const MEMb = (bf16*)(ws + WS_MEMB);
    bf16* const QKP = (bf16*)(ws + WS_QKP); bf16* const VT = (bf16*)(ws + WS_VT); bf16* const MK = (bf16*)(ws + WS_MK); bf16* const MVT = (bf16*)(ws + WS_MVT);
    bf16* const GATES = (bf16*)(ws + WS_GATES); bf16* const BR = (bf16*)(ws + WS_BR); float* const PART = (float*)(ws + WS_PART); bf16* const MIXED = (bf16*)(ws + WS_MIXED);
    bf16* const H1b = (bf16*)(ws + WS_H1B); bf16* const Wup_t = (bf16*)(ws + WS_WUP); bf16* const Wdown_t = (bf16*)(ws + WS_WDOWN); bf16* const U = (bf16*)(ws + WS_U); bf16* const ACT = (bf16*)(ws + WS_ACT);
    const int gw = vcu * NWAVES + wave, NGW = G * NWAVES;
#define TJOB(src, ldw, K, ncols, dst) { const int n_ = ((K) / 64) * ((ncols) / 64); if (r < n_) { transpose_item((src), (ldw), (K), (ncols), (dst), r, lane); continue; } r -= n_; }

    if (IN(0)) {
        const float* w_in = args.in[I_WIN];
        constexpr int I1 = 32 * 16, I2 = 32 * 4;
        constexpr int NIT = 5 * I1 + 2 * I2 + 32 * (NG / 64) + 32 * 32 + 3 * (16 * 32) + 32 * 32;
        for (int it = gw; it < NIT; it += NGW) {
            int r = it;
            TJOB(w_in + 0, IN_W, 2048, 1024, WinQK_t + (size_t)C_DQ * 2048)
            TJOB(w_in + 1024, IN_W, 2048, 1024, WinQK_t + (size_t)C_DK * 2048)
            TJOB(w_in + 2048, IN_W, 2048, 1024, WinV_t)
            TJOB(w_in + 3072, IN_W, 2048, 1024, WinQK_t + (size_t)C_WQ * 2048)
            TJOB(w_in + 4096, IN_W, 2048, 256, WinQK_t + (size_t)C_WK * 2048)
            TJOB(w_in + 4352, IN_W, 2048, 256, WinV_t + (size_t)1024 * 2048)
            TJOB(w_in + 4608, IN_W, 2048, 1024, WinQK_t + (size_t)C_MQ * 2048)
            TJOB(args.in[I_WGATE], NG, 2048, NG, Wgate_t)
            TJOB(args.in[I_WMEM], 2048, 2048, 2048, Wmem_t)
            TJOB(args.in[I_WBR], 2048, 1024, 2048, Wbr_t)
            TJOB(args.in[I_WBR] + (size_t)1024 * 2048, 2048, 1024, 2048, Wbr_t + (size_t)2048 * 1024)
            TJOB(args.in[I_WBR] + (size_t)2 * 1024 * 2048, 2048, 1024, 2048, Wbr_t + (size_t)2 * 2048 * 1024)
            TJOB(args.in[I_WO], 2048, 2048, 2048, Wo_t)
        }
        for (int m = gw; m < T; m += NGW) ln_row(args.in[I_X] + (size_t)m * D, args.in[I_LNG], args.in[I_LNB], out + (size_t)m * D, H0b + (size_t)m * D, lane);
        for (int m = gw; m < TM; m += NGW) { const GAS f32x4* xr = (const GAS f32x4*)(args.in[I_MEM] + (size_t)m * D) + lane; GAS v2u* o = (GAS v2u*)(MEMb + (size_t)m * D) + lane;
#pragma unroll
            for (int j = 0; j < 8; ++j) { const f32x4 v = xr[64 * j]; o[64 * j] = (v2u){pk2(v.x, v.y), pk2(v.z, v.w)}; } }
        if (IN(1)) GRID_BAR();
    }

    if (IN(1)) {
        pg8::Gemm g{nullptr, nullptr, 2048, 2048, 0, 0, 2048};
        pg8::MultiOrder S; S.G = G; S.c = bx;
        S.nM0 = T / 256;  S.nN0 = NG / 256;
        S.nM1 = T / 256;  S.nN1 = NQK / 256;
        S.nM2 = NV / 256; S.nN2 = T / 256;
        S.nM3 = TM / 256; S.nN3 = 1024 / 256;
        S.nM4 = 1024 / 256; S.nN4 = TM / 256;
        S.total = S.nM0 * S.nN0 + S.nM1 * S.nN1 + S.nM2 * S.nN2 + S.nM3 * S.nN3 + S.nM4 * S.nN4;
        pg8::MultiPtrs P{H0b, Wgate_t, H0b, WinQK_t, WinV_t, H0b, MEMb, Wmem_t, Wmem_t + (size_t)1024 * 2048, MEMb};
        pg8::EpiBf16Multi E{pg8::EpiBf16{GATES, NG, args.in[I_BGATE], 2}, pg8::EpiBf16{QKP, NQK, nullptr, 0}, pg8::EpiBf16{VT, T, nullptr, 0}, pg8::EpiBf16{MK, 1024, nullptr, 0}, pg8::EpiBf16{MVT, TM, nullptr, 0}};
        pg8::gemm_phase<pg8::EpiBf16Multi, pg8::MultiOrder, pg8::MultiPtrs>(lds, g, S, P, E);
        if (IN(2)) GRID_BAR();
    }

    if (IN(2)) {
        phase_attention(lds, args, QKP, VT, MK, MVT, BR, vcu, G, wave, lane);
        if (IN(3)) GRID_BAR();
    }

    if (IN(3)) {
        for (int i = 0; i < 3; ++i) {
            pg8::Gemm g{BR + i * 1024, Wbr_t + (size_t)i * 2048 * 1024, NBR, 1024, T, D, 1024};
            pg8::EpiGate E{GATES + i * 2048, NG, PART, D, MIXED, D, i};
            pg8::StaticOrder S; S.init(T, D, G, bx); pg8::SinglePtrs P{g.A, g.Bt};
            pg8::gemm_phase<pg8::EpiGate, pg8::StaticOrder, pg8::SinglePtrs>(lds, g, S, P, E);
        }
        if (IN(4)) GRID_BAR();
    }

    if (IN(4)) {
        pg8::Gemm g{MIXED, Wo_t, 2048, 2048, T, D, 2048}; pg8::EpiResid E{out, D, ALPHA};
        pg8::StaticOrder S; S.init(T, D, G, bx); pg8::SinglePtrs P{g.A, g.Bt};
        pg8::gemm_phase<pg8::EpiResid, pg8::StaticOrder, pg8::SinglePtrs>(lds, g, S, P, E);
        if (IN(5)) GRID_BAR();
    }

    if (IN(5)) {
        for (int m = gw; m < T; m += NGW) ln_row(out + (size_t)m * D, args.in[I_LN1G], args.in[I_LN1B], out + (size_t)m * D, H1b + (size_t)m * D, lane);
        constexpr int NIT = 32 * (NUP / 64) + (DFF / 64) * 32;
        for (int it = gw; it < NIT; it += NGW) {
            int r = it;
            TJOB(args.in[I_WUP], NUP, 2048, NUP, Wup_t)
            TJOB(args.in[I_WDOWN], 2048, DFF, 2048, Wdown_t)
        }
        if (IN(6)) GRID_BAR();
    }

    if (IN(6)) {
        pg8::Gemm g{H1b, Wup_t, 2048, 2048, T, NUP, 2048}; pg8::EpiBf16 E; E.O = U; E.ldc = NUP; E.bias = nullptr; E.act = 0;
        pg8::StaticOrder S; S.init(T, NUP, G, bx); pg8::SinglePtrs P{g.A, g.Bt};
        pg8::gemm_phase<pg8::EpiBf16, pg8::StaticOrder, pg8::SinglePtrs>(lds, g, S, P, E);
        if (IN(7)) GRID_BAR();
    }

    if (IN(7)) {
        const float* cw = args.in[I_CONVW]; const float* cb = args.in[I_CONVB];
        constexpr int NCH = DFF / 8, RUN = 8, NITEM = (T / RUN) * NCH;
        for (int item = bx * (NWAVES * 64) + tid; item < NITEM; item += G * NWAVES * 64) {
            const int tr = item / NCH, c = item % NCH, t0 = tr * RUN, n0 = c * 8;
            v4u ra[RUN + 2], rb[RUN + 2];
#pragma unroll
            for (int i = 0; i < RUN + 2; ++i) {
                const int t = t0 - 1 + i; const bool zero = (i == 0 && (t0 % SEQ) == 0) || (i == RUN + 1 && ((t0 + RUN) % SEQ) == 0);
                if (zero) { ra[i] = (v4u){0u, 0u, 0u, 0u}; rb[i] = (v4u){0u, 0u, 0u, 0u}; }
                else { ra[i] = *(const GAS v4u*)(U + (size_t)t * NUP + n0); rb[i] = *(const GAS v4u*)(U + (size_t)t * NUP + DFF + n0); }
            }
            float w0[16], w1[16], w2[16], bb[16];
#pragma unroll
            for (int e = 0; e < 8; ++e) { w0[e] = cw[n0 + e]; w1[e] = cw[NUP + n0 + e]; w2[e] = cw[2 * NUP + n0 + e]; bb[e] = cb[n0 + e];
                w0[8 + e] = cw[DFF + n0 + e]; w1[8 + e] = cw[NUP + DFF + n0 + e]; w2[8 + e] = cw[2 * NUP + DFF + n0 + e]; bb[8 + e] = cb[DFF + n0 + e]; }
#define UNPK(dst, a_, b_) do { dst[0] = bflo(a_.x); dst[1] = bfhi(a_.x); dst[2] = bflo(a_.y); dst[3] = bfhi(a_.y); dst[4] = bflo(a_.z); dst[5] = bfhi(a_.z); dst[6] = bflo(a_.w); dst[7] = bfhi(a_.w); \
                dst[8] = bflo(b_.x); dst[9] = bfhi(b_.x); dst[10] = bflo(b_.y); dst[11] = bfhi(b_.y); dst[12] = bflo(b_.z); dst[13] = bfhi(b_.z); dst[14] = bflo(b_.w); dst[15] = bfhi(b_.w); } while (0)
#pragma unroll
            for (int tt = 0; tt < RUN; ++tt) {
                float prev[16], cur[16], nxt[16];
                UNPK(prev, ra[tt], rb[tt]); UNPK(cur, ra[tt + 1], rb[tt + 1]); UNPK(nxt, ra[tt + 2], rb[tt + 2]);
                float o[8];
#pragma unroll
                for (int e = 0; e < 8; ++e) { const float val = prev[e] * w0[e] + cur[e] * w1[e] + nxt[e] * w2[e] + bb[e];
                    const float gt = prev[8 + e] * w0[8 + e] + cur[8 + e] * w1[8 + e] + nxt[8 + e] * w2[8 + e] + bb[8 + e]; o[e] = gelu_tanh(gt) * val; }
                *(GAS v4u*)(ACT + (size_t)(t0 + tt) * DFF + n0) = (v4u){pk2(o[0], o[1]), pk2(o[2], o[3]), pk2(o[4], o[5]), pk2(o[6], o[7])};
            }
#undef UNPK
        }
        if (IN(8)) GRID_BAR();
    }

    if (IN(8)) {
        pg8::Gemm g{ACT, Wdown_t, DFF, DFF, T, D, DFF}; pg8::EpiResid E{out, D, ALPHA};
        pg8::StaticOrder S; S.init(T, D, G, bx); pg8::SinglePtrs P{g.A, g.Bt};
        pg8::gemm_phase<pg8::EpiResid, pg8::StaticOrder, pg8::SinglePtrs>(lds, g, S, P, E);
        if (IN(9)) GRID_BAR();
    }

    if (IN(9)) {
        for (int m = gw; m < T; m += NGW) ln_row(out + (size_t)m * D, args.in[I_LN2G], args.in[I_LN2B], out + (size_t)m * D, nullptr, lane);
    }
#undef IN
#undef TJOB
#undef GRID_BAR
}

extern "C" void kernel_launch(void* const* d_in, const int* in_sizes, int n_in, void* d_out, int out_size, void* d_ws, size_t ws_size, hipStream_t stream) {
    static int grid = 0;
    if (grid == 0) {
        if (n_in != 25 || in_sizes[0] != T * D || out_size != T * D || ws_size < WS_END) { fprintf(stderr, "kernel_launch: unexpected shapes (n_in %d, in0 %d, out %d, ws %zu < %zu)\n", n_in, n_in > 0 ? in_sizes[0] : -1, out_size, ws_size, (size_t)WS_END); grid = -1; return; }
        int dev = 0, cus = 0, per_cu = 0;
        if (hipGetDevice(&dev) != hipSuccess || hipDeviceGetAttribute(&cus, hipDeviceAttributeMultiprocessorCount, dev) != hipSuccess) { fprintf(stderr, "kernel_launch: device query failed\n"); grid = -1; return; }
        if (hipFuncSetAttribute((const void*)mega_fwd, hipFuncAttributeMaxDynamicSharedMemorySize, LDS_BYTES) != hipSuccess) { fprintf(stderr, "kernel_launch: hipFuncSetAttribute failed\n"); grid = -1; return; }
        if (hipOccupancyMaxActiveBlocksPerMultiprocessor(&per_cu, (const void*)mega_fwd, NWAVES * 64, LDS_BYTES) != hipSuccess || per_cu < 1)
            fprintf(stderr, "kernel_launch: note: occupancy query reports %d workgroups per CU\n", per_cu);
        (void)hipGetLastError();
        grid = cus;
    }
    if (grid < 0) return;
    if (hipMemsetAsync((char*)d_ws + WS_CTL, 0, CTL_ZERO_BYTES, stream) != hipSuccess) { fprintf(stderr, "kernel_launch: memset failed\n"); return; }
    Args a{};
    for (int i = 0; i < 25; ++i) a.in[i] = (const float*)d_in[i];
    a.out = (float*)d_out; a.ws = (unsigned char*)d_ws;
    if (N_LAUNCHES == 1) { a.ph_lo = 0; a.ph_hi = N_PHASES; hipLaunchKernelGGL(mega_fwd, dim3(grid), dim3(NWAVES * 64), LDS_BYTES, stream, a); }
    else for (int li = 0; li < N_PHASES; ++li) { a.ph_lo = li; a.ph_hi = li + 1; hipLaunchKernelGGL(mega_fwd, dim3(grid), dim3(NWAVES * 64), LDS_BYTES, stream, a); }
    const hipError_t le = hipPeekAtLastError();
    if (le != hipSuccess) fprintf(stderr, "kernel_launch: launch failed: %s\n", hipGetErrorName(le));
}
```

```cpp
#include <hip/hip_runtime.h>
#include <cstdio>
#include <cstdint>
#include <cmath>
namespace pg8 {
#define PG8_LAS __attribute__((address_space(3)))
typedef unsigned short bf16_t;
typedef short bf16x8 __attribute__((ext_vector_type(8)));
typedef float f32x4 __attribute__((ext_vector_type(4)));
typedef float f32x2 __attribute__((ext_vector_type(2)));
typedef unsigned u32x4 __attribute__((ext_vector_type(4)));
typedef unsigned u32x2 __attribute__((ext_vector_type(2)));
constexpr int BM = 256, BK = 64, HALF = 128, HTB = HALF * BK * 2  , STAGE_BYTES = 8 * HTB, NXCD = 8, WGM = 8;

__host__ __device__ __forceinline__ int lds_byte(int r, int c) { const int st = (r >> 4) * 2 + (c >> 5), rr = r & 15, cc = c & 31, ob = rr * 64 + cc * 2; return st * 1024 + (ob ^ (((ob >> 9) & 1) << 5)); }
__host__ __device__ __forceinline__ void stage_rc(int b, int& R, int& C) { const int st = b / 1024, sb = b % 1024, swz = sb ^ (((sb >> 9) & 1) << 5); R = (st >> 1) * 16 + swz / 64; C = (st & 1) * 32 + (swz % 64) / 2; }
__host__ __device__ __forceinline__ int perm32(int rho) { const int n = rho >> 4, i = rho & 15; return 8 * (i >> 2) + 4 * n + (i & 3); }

struct Unit { int pm, pn, job; };
struct Gemm { const bf16_t* A; const bf16_t* Bt; int lda, ldb, M, N, K; };

struct StaticOrder {
    int nM, nN, nwg, G, c;
    __host__ __device__ void init(int M, int N, int G_, int c_) { nM = M / BM; nN = N / BM; nwg = nM * nN; G = G_; c = c_; }
    __host__ __device__ bool next(int i, Unit& u) const {
        const long L = (long)i * G + c; if (L >= nwg) return false;
        int wgid = (int)L; { const int q = nwg / NXCD, r = nwg % NXCD, xcd = wgid % NXCD, off = wgid / NXCD; wgid = (xcd < r ? xcd * (q + 1) : r * (q + 1) + (xcd - r) * q) + off; }
        const int nig = WGM * nN, gid = wgid / nig, fm = gid * WGM, gsz = (nM - fm) < WGM ? (nM - fm) : WGM;
        u.pm = fm + ((wgid % nig) % gsz); u.pn = (wgid % nig) / gsz; u.job = 0; return true;
    }
};
struct MultiOrder {
    int nM0, nN0, nM1, nN1, nM2, nN2, nM3, nN3, nM4, nN4, total, G, c;
    __host__ __device__ bool next(int i, Unit& u) const {
        const long L = (long)i * G + c; if (L >= total) return false;
        int wgid = (int)L; { const int q = total / NXCD, r = total % NXCD, xcd = wgid % NXCD, off = wgid / NXCD; wgid = (xcd < r ? xcd * (q + 1) : r * (q + 1) + (xcd - r) * q) + off; }
        int j = 0, m_ = nM0, n_ = nN0;
        if (wgid >= m_ * n_) { wgid -= m_ * n_; j = 1; m_ = nM1; n_ = nN1;
            if (wgid >= m_ * n_) { wgid -= m_ * n_; j = 2; m_ = nM2; n_ = nN2;
                if (wgid >= m_ * n_) { wgid -= m_ * n_; j = 3; m_ = nM3; n_ = nN3;
                    if (wgid >= m_ * n_) { wgid -= m_ * n_; j = 4; m_ = nM4; n_ = nN4; } } } }
        const int nig = WGM * n_, gid = wgid / nig, fm = gid * WGM, gsz = (m_ - fm) < WGM ? (m_ - fm) : WGM;
        u.pm = fm + ((wgid % nig) % gsz); u.pn = (wgid % nig) / gsz; u.job = j; return true;
    }
};

__device__ __forceinline__ unsigned cvt_pk_bf16(float lo, float hi) { unsigned r; asm volatile("v_cvt_pk_bf16_f32 %0, %1, %2" : "=v"(r) : "v"(lo), "v"(hi)); return r; }
__device__ __forceinline__ float bf_lo(unsigned w) { return __uint_as_float(w << 16); }
__device__ __forceinline__ float bf_hi(unsigned w) { return __uint_as_float(w & 0xffff0000u); }
__device__ __forceinline__ float sigmoidf_(float z) { return __builtin_amdgcn_rcpf(1.0f + __builtin_amdgcn_exp2f(-1.4426950408889634f * z)); }

struct EpiBf16 {
    static constexpr bool PERM = true, MIDK = false;
    bf16_t* O; int ldc; const float* bias; int act;
    __device__ __forceinline__ void operator()(const f32x4 (&acc)[2][2][4][2], const Unit& u, int wr, int wc, int fr, int fq) const {
        const int row0 = u.pm * BM + wr * 64 + fr; const int col0 = u.pn * BM + wc * 32 + 8 * fq;
        f32x4 bv[2][2];
#pragma unroll
        for (int bj = 0; bj < 2; ++bj)
#pragma unroll
            for (int n = 0; n < 2; ++n) bv[bj][n] = bias ? *(const f32x4*)(bias + col0 + bj * HALF + 4 * n) : (f32x4){0.f, 0.f, 0.f, 0.f};
#pragma unroll
        for (int ai = 0; ai < 2; ++ai)
#pragma unroll
            for (int m = 0; m < 4; ++m) { bf16_t* rowp = O + (size_t)(row0 + ai * HALF + m * 16) * ldc + col0;
#pragma unroll
                for (int bj = 0; bj < 2; ++bj) { f32x4 v0 = acc[ai][bj][m][0] + bv[bj][0], v1 = acc[ai][bj][m][1] + bv[bj][1];
                    if (act == 2) {
#pragma unroll
                        for (int e = 0; e < 4; ++e) { v0[e] = sigmoidf_(v0[e]); v1[e] = sigmoidf_(v1[e]); } }
                    u32x4 w; w.x = cvt_pk_bf16(v0[0], v0[1]); w.y = cvt_pk_bf16(v0[2], v0[3]); w.z = cvt_pk_bf16(v1[0], v1[1]); w.w = cvt_pk_bf16(v1[2], v1[3]);
                    *(u32x4*)(rowp + bj * HALF) = w; } }
    }
};

struct EpiBf16Multi {
    static constexpr bool PERM = true, MIDK = false;
    EpiBf16 e0, e1, e2, e3, e4;
    __device__ __forceinline__ void operator()(const f32x4 (&acc)[2][2][4][2], const Unit& u, int wr, int wc, int fr, int fq) const {
        const int j = u.job; EpiBf16 x;
        x.O = j == 1 ? e1.O : j == 2 ? e2.O : j == 3 ? e3.O : j == 4 ? e4.O : e0.O;
        x.ldc = j == 1 ? e1.ldc : j == 2 ? e2.ldc : j == 3 ? e3.ldc : j == 4 ? e4.ldc : e0.ldc;
        x.bias = j == 1 ? e1.bias : j == 2 ? e2.bias : j == 3 ? e3.bias : j == 4 ? e4.bias : e0.bias;
        x.act = j == 1 ? e1.act : j == 2 ? e2.act : j == 3 ? e3.act : j == 4 ? e4.act : e0.act;
        x(acc, u, wr, wc, fr, fq);
    }
};

struct EpiGate {
    static constexpr bool PERM = true, MIDK = true;
    const bf16_t* G; int ldg; bf16_t* O; int ldo;
    __device__ __forceinline__ void mid(f32x4 (&acc)[2][2][4][2], const Unit& u, int seg  , int wr, int wc, int fr, int fq) const {
        const char* gbase = (const char*)G + (size_t)(seg - 1) * 4096;
        const unsigned off0 = (unsigned)((u.pm * BM + wr * 64 + fr) * ldg + u.pn * BM + wc * 32 + 8 * fq) * 2u, rstep = (unsigned)ldg * 32u;
#pragma unroll
        for (int ai = 0; ai < 2; ++ai)
#pragma unroll
            for (int m = 0; m < 4; ++m) { const unsigned off = off0 + (unsigned)(ai * 8 + m) * rstep;
                u32x4 ga[2], gb[2];
#pragma unroll
                for (int bj = 0; bj < 2; ++bj) { ga[bj] = *(const u32x4*)(gbase + off + bj * 256); gb[bj] = *(const u32x4*)(gbase + off + 4096 + bj * 256); }
#pragma unroll
                for (int bj = 0; bj < 2; ++bj)
#pragma unroll
                    for (int e = 0; e < 4; ++e) {
                        const float r0 = bf_lo(ga[bj][e]) * __builtin_amdgcn_rcpf(fmaxf(bf_lo(gb[bj][e]), 1e-30f)), r1 = bf_hi(ga[bj][e]) * __builtin_amdgcn_rcpf(fmaxf(bf_hi(gb[bj][e]), 1e-30f));
                        acc[ai][bj][m][e >> 1][2 * (e & 1)] *= r0; acc[ai][bj][m][e >> 1][2 * (e & 1) + 1] *= r1; }
                asm volatile("" ::: "memory"); }
    }
    __device__ __forceinline__ void operator()(const f32x4 (&acc)[2][2][4][2], const Unit& u, int wr, int wc, int fr, int fq) const {
        const int row0 = u.pm * BM + wr * 64 + fr, col0 = u.pn * BM + wc * 32 + 8 * fq;
#pragma unroll
        for (int ai = 0; ai < 2; ++ai)
#pragma unroll
            for (int m = 0; m < 4; ++m) { const size_t row = (size_t)(row0 + ai * HALF + m * 16);
#pragma unroll
                for (int bj = 0; bj < 2; ++bj) { const u32x4 g = *(const u32x4*)(G + row * ldg + 2 * 2048 + col0 + bj * HALF);
                    const f32x4 v0 = acc[ai][bj][m][0], v1 = acc[ai][bj][m][1];
                    u32x4 w; w.x = cvt_pk_bf16(v0[0] * bf_lo(g.x), v0[1] * bf_hi(g.x)); w.y = cvt_pk_bf16(v0[2] * bf_lo(g.y), v0[3] * bf_hi(g.y));
                    w.z = cvt_pk_bf16(v1[0] * bf_lo(g.z), v1[1] * bf_hi(g.z)); w.w = cvt_pk_bf16(v1[2] * bf_lo(g.w), v1[3] * bf_hi(g.w));
                    *(u32x4*)(O + row * ldo + col0 + bj * HALF) = w; } }
    }
};

struct EpiResid {
    static constexpr bool PERM = false, MIDK = false;
    float* C; int ldc; float alpha;
    __device__ __forceinline__ void operator()(const f32x4 (&acc)[2][2][4][2], const Unit& u, int wr, int wc, int fr, int fq) const {
        const int row0 = u.pm * BM + wr * 64 + fr, col0 = u.pn * BM + wc * 32 + 4 * fq;
#pragma unroll
        for (int ai = 0; ai < 2; ++ai)
#pragma unroll
            for (int m = 0; m < 4; ++m) { float* rowp = C + (size_t)(row0 + ai * HALF + m * 16) * ldc + col0;
#pragma unroll
                for (int bj = 0; bj < 2; ++bj)
#pragma unroll
                    for (int n = 0; n < 2; ++n) { f32x4* p = (f32x4*)(rowp + bj * HALF + n * 16); *p = *p * alpha + acc[ai][bj][m][n]; } }
    }
};

struct SinglePtrs { const bf16_t* A; const bf16_t* Bt;
    __device__ __forceinline__ void bases(const Unit& u, size_t tA, size_t tB, const char*& a, const char*& b) const { a = (const char*)A + (size_t)u.pm * tA; b = (const char*)Bt + (size_t)u.pn * tB; } };
struct MultiPtrs { const bf16_t *A0, *B0, *A1, *B1, *A2, *B2, *A3, *B3, *A4, *B4;
    __device__ __forceinline__ void bases(const Unit& u, size_t tA, size_t tB, const char*& a, const char*& b) const {
        const int j = u.job;
        const bf16_t* pa = j == 1 ? A1 : j == 2 ? A2 : j == 3 ? A3 : j == 4 ? A4 : A0;
        const bf16_t* pb = j == 1 ? B1 : j == 2 ? B2 : j == 3 ? B3 : j == 4 ? B4 : B0;
        a = (const char*)pa + (size_t)u.pm * tA; b = (const char*)pb + (size_t)u.pn * tB; } };

template <class Epi, class Sched, class Ptrs, bool ALIGN_EPI = true>
__device__ __forceinline__ void gemm_phase(PG8_LAS unsigned char* lds, const Gemm g, const Sched& S, const Ptrs& P, const Epi& E) {
    const int tid = threadIdx.x, wid = __builtin_amdgcn_readfirstlane(tid >> 6), lane = tid & 63, wr = wid >> 2, wc = wid & 3, fr = lane & 15, fq = lane >> 4;
    const int K = g.K, nt = K / BK;
    unsigned voffA[2], voffB[2];
#pragma unroll
    for (int i = 0; i < 2; ++i) { int R, C; stage_rc(tid * 16 + i * 8192, R, C); const int Rb = Epi::PERM ? ((R & ~31) + perm32(R & 31)) : R;
        voffA[i] = (unsigned)(R * g.lda + C) * 2u; voffB[i] = (unsigned)(Rb * g.ldb + C) * 2u; }
    const size_t kstep = (size_t)(BK * 2);
    const size_t hA = (size_t)HALF * g.lda * 2, hB = (size_t)HALF * g.ldb * 2;
    const size_t tA = 2 * hA, tB = 2 * hB;
    const unsigned ldsw = (unsigned)wid * 1024u;
    const int aoff = lds_byte(wr * 64 + fr, fq * 8), boff = lds_byte(wc * 32 + fr, fq * 8);
#define PG8_SA(b, h) (((b) * 2 + (h)) * HTB)
#define PG8_SB(b, h) ((4 + (b) * 2 + (h)) * HTB)
#define PG8_STAGE(bufoff, gbase, voff) do { _Pragma("unroll") for (int _i = 0; _i < 2; ++_i) \
        __builtin_amdgcn_global_load_lds((const unsigned*)((const char*)(gbase) + (voff)[_i]), (PG8_LAS unsigned*)(lds + (bufoff) + ldsw + _i * 8192), 16, 0, 0); } while (0)
#define PG8_LDA(dst, b, h) do { _Pragma("unroll") for (int m = 0; m < 4; ++m) _Pragma("unroll") for (int k = 0; k < 2; ++k) dst[m][k] = *(const PG8_LAS bf16x8*)(lds + PG8_SA(b, h) + aoff + m * 2048 + k * 1024); } while (0)
#define PG8_LDB(dst, b, h) do { _Pragma("unroll") for (int n = 0; n < 2; ++n) _Pragma("unroll") for (int k = 0; k < 2; ++k) dst[n][k] = *(const PG8_LAS bf16x8*)(lds + PG8_SB(b, h) + boff + n * 2048 + k * 1024); } while (0)
#define PG8_MMA(ai, bj, At, Bt) do { __builtin_amdgcn_s_setprio(1); _Pragma("unroll") for (int m = 0; m < 4; ++m) _Pragma("unroll") for (int n = 0; n < 2; ++n) _Pragma("unroll") for (int k = 0; k < 2; ++k) \
        acc[ai][bj][m][n] = __builtin_amdgcn_mfma_f32_16x16x32_bf16(Bt[n][k], At[m][k], acc[ai][bj][m][n], 0, 0, 0); __builtin_amdgcn_s_setprio(0); } while (0)
#define PG8_WAIT_V(n) asm volatile("s_waitcnt vmcnt(" #n ")" ::: "memory")
#define PG8_WAIT_L(n) asm volatile("s_waitcnt lgkmcnt(" #n ")" ::: "memory")
#define PG8_BAR __builtin_amdgcn_s_barrier()
#define PG8_SCHED __builtin_amdgcn_sched_barrier(0)
    Unit cur, nxt; int ui = 0;
    if (!S.next(0, cur)) return;
    f32x4 acc[2][2][4][2];
#pragma unroll
    for (int a = 0; a < 2; ++a)
#pragma unroll
        for (int b = 0; b < 2; ++b)
#pragma unroll
            for (int m = 0; m < 4; ++m)
#pragma unroll
                for (int n = 0; n < 2; ++n) acc[a][b][m][n] = (f32x4){0.f, 0.f, 0.f, 0.f};
    bf16x8 At[4][2], B0[2][2], B1[2][2];
    const char* cA; const char* cB; P.bases(cur, tA, tB, cA, cB);
    PG8_STAGE(PG8_SB(0, 0), cB, voffB); PG8_STAGE(PG8_SB(0, 1), cB + hB, voffB); PG8_STAGE(PG8_SA(0, 0), cA, voffA); PG8_STAGE(PG8_SA(0, 1), cA + hA, voffA);
    if (wr == 1) PG8_BAR;
    PG8_WAIT_V(2); PG8_BAR;
    PG8_STAGE(PG8_SB(1, 0), cB + kstep, voffB); PG8_STAGE(PG8_SA(1, 0), cA + kstep, voffA); PG8_STAGE(PG8_SB(1, 1), cB + hB + kstep, voffB);
    PG8_WAIT_V(6); PG8_BAR;
    for (;;) {
        const bool has_next = S.next(ui + 1, nxt);
        const char* nA = cA; const char* nB = cB; if (has_next) P.bases(nxt, tA, tB, nA, nB);
        for (int t = 0; t < nt; t += 2) {
            const bool last = (t == nt - 2);
            const char* a1 = cA + (size_t)(t + 1) * kstep;
            const char* a2 = last ? nA : cA + (size_t)(t + 2) * kstep; const char* b2 = last ? nB : cB + (size_t)(t + 2) * kstep;
            const char* a3 = a2 + kstep; const char* b3 = b2 + kstep;
            if constexpr (Epi::MIDK) { if (t == 16 || t == 32) E.mid(acc, cur, t >> 4, wr, wc, fr, fq); }
            PG8_LDB(B0, 0, 0); PG8_LDB(B1, 0, 1); PG8_SCHED; PG8_LDA(At, 0, 0); PG8_STAGE(PG8_SA(1, 1), a1 + hA, voffA);
            PG8_WAIT_V(8); PG8_WAIT_L(0); PG8_BAR; PG8_MMA(0, 0, At, B0); PG8_MMA(0, 1, At, B1); PG8_BAR; PG8_SCHED;
            PG8_LDA(At, 0, 1); PG8_STAGE(PG8_SB(0, 0), b2, voffB); PG8_STAGE(PG8_SB(0, 1), b2 + hB, voffB); PG8_STAGE(PG8_SA(0, 0), a2, voffA);
            PG8_WAIT_V(8); PG8_WAIT_L(0); PG8_BAR; PG8_MMA(1, 0, At, B0); PG8_MMA(1, 1, At, B1); PG8_BAR; PG8_SCHED;
            PG8_LDB(B0, 1, 0); PG8_LDB(B1, 1, 1); PG8_SCHED; PG8_LDA(At, 1, 0); PG8_STAGE(PG8_SA(0, 1), a2 + hA, voffA);
            PG8_WAIT_V(8); PG8_WAIT_L(0); PG8_BAR; PG8_MMA(0, 0, At, B0); PG8_MMA(0, 1, At, B1); PG8_BAR; PG8_SCHED;
            PG8_LDA(At, 1, 1); PG8_STAGE(PG8_SB(1, 0), b3, voffB); PG8_STAGE(PG8_SB(1, 1), b3 + hB, voffB); PG8_STAGE(PG8_SA(1, 0), a3, voffA);
            PG8_WAIT_V(8); PG8_WAIT_L(0); PG8_BAR; PG8_MMA(1, 0, At, B0); PG8_MMA(1, 1, At, B1); PG8_BAR; PG8_SCHED;
        }
        if constexpr (ALIGN_EPI) { if (wr == 0) PG8_BAR; }
        E(acc, cur, wr, wc, fr, fq);
        if (!has_next) break;
#pragma unroll
        for (int a = 0; a < 2; ++a)
#pragma unroll
            for (int b = 0; b < 2; ++b)
#pragma unroll
                for (int m = 0; m < 4; ++m)
#pragma unroll
                    for (int n = 0; n < 2; ++n) acc[a][b][m][n] = (f32x4){0.f, 0.f, 0.f, 0.f};
        cur = nxt; cA = nA; cB = nB; ++ui;
        if constexpr (ALIGN_EPI) { if (wr == 1) PG8_BAR; }
    }
    PG8_WAIT_V(0);
    if constexpr (!ALIGN_EPI) { if (wr == 0) PG8_BAR; }
    PG8_BAR;
#undef PG8_SA
#undef PG8_SB
#undef PG8_STAGE
#undef PG8_LDA
#undef PG8_LDB
#undef PG8_MMA
#undef PG8_WAIT_V
#undef PG8_WAIT_L
#undef PG8_BAR
#undef PG8_SCHED
}
}
namespace att {
#define ATT_LAS __attribute__((address_space(3)))
typedef unsigned short bf16_t;
typedef short bf16x8 __attribute__((ext_vector_type(8)));
typedef short s16x4 __attribute__((ext_vector_type(4)));
typedef float f32x16 __attribute__((ext_vector_type(16)));
typedef unsigned u32x4 __attribute__((ext_vector_type(4)));
typedef unsigned u32x2 __attribute__((ext_vector_type(2)));
constexpr float LOG2E = 1.4426950408889634f;
constexpr float NEGBIG = -1e30f;
constexpr int VROW = 136;
constexpr int BIAS_OFF = 60 * 1024;
constexpr int BIAS_STRIDE = 1040;

__device__ __forceinline__ unsigned pk_bf16(float lo, float hi) { unsigned r; asm volatile("v_cvt_pk_bf16_f32 %0, %1, %2" : "=v"(r) : "v"(lo), "v"(hi)); return r; }

__device__ __forceinline__ int t5_bucket(int rel) {
    const int n = rel < 0 ? -rel : rel; const int ret = rel > 0 ? 16 : 0;
    const float nf = (float)(n < 1 ? 1 : n);
    int large = 8 + (int)(logf(nf / 8.0f) / 2.7725887222397811f * 8.0f);
    large = large < 15 ? large : 15;
    return ret + (n < 8 ? n : large);
}
__device__ __forceinline__ void fill_bias(ATT_LAS unsigned char* lds, int t, const float* rel_table, int col) {
    ATT_LAS float* tab = (ATT_LAS float*)(lds + BIAS_OFF + t * BIAS_STRIDE);
    for (int i = threadIdx.x; i < 257; i += 512) tab[i] = rel_table[t5_bucket(i - 128) * 16 + col] * LOG2E;
}

struct Desc {
    const bf16_t* Qw; int ldq;
    const bf16_t* K;  int ldk;
    const bf16_t* Vt; int ldv;
    bf16_t* Ow; int ldo;
    int qpos0;
    int kt0, kt1;
    int btab;
    float sc2;
    float sink2;
    float lam;
    const float* subg;
};

template <int NMAP, int DQK, bool BIAS, bool WIN, bool SUBLN>
__device__ __forceinline__ void attn_unit(ATT_LAS unsigned char* lds, const Desc& D) {
    constexpr int DKT = NMAP * DQK, KROW = DKT * 2 + 16, CPR = DKT / 8, NKC = 64 * CPR / 512, NDC = DQK / 16;
    constexpr int LDS_K = 0, LDS_V = 64 * KROW;
    static_assert(LDS_V + 128 * VROW <= BIAS_OFF, "attention LDS map");
    const int tid = threadIdx.x, lane = tid & 63, r = lane & 31, h = lane >> 5;
    bf16x8 qf[NMAP][NDC];
#pragma unroll
    for (int c = 0; c < NMAP; ++c)
#pragma unroll
        for (int dc = 0; dc < NDC; ++dc) qf[c][dc] = *(const bf16x8*)(D.Qw + (size_t)r * D.ldq + c * DQK + 16 * dc + 8 * h);
    const ATT_LAS float* tab = (const ATT_LAS float*)(lds + BIAS_OFF + D.btab * BIAS_STRIDE);
    const int qpos = D.qpos0 + r;
    u32x4 kreg[NKC], vreg[2];
#define ATT_LOADK(kt) do { _Pragma("unroll") for (int i = 0; i < NKC; ++i) { const int c = tid + 512 * i, row = c / CPR, cc = c % CPR; \
        kreg[i] = *(const u32x4*)(D.K + (size_t)((kt) * 64 + row) * D.ldk + cc * 8); } } while (0)
#define ATT_STOREK() do { _Pragma("unroll") for (int i = 0; i < NKC; ++i) { const int c = tid + 512 * i, row = c / CPR, cc = c % CPR; \
        *(ATT_LAS u32x4*)(lds + LDS_K + row * KROW + cc * 16) = kreg[i]; } } while (0)
#define ATT_LOADV(kt) do { _Pragma("unroll") for (int i = 0; i < 2; ++i) { const int c = tid + 512 * i, row = c >> 3, cc = c & 7; \
        vreg[i] = *(const u32x4*)(D.Vt + (size_t)row * D.ldv + (kt) * 64 + cc * 8); } } while (0)
#define ATT_STOREV() do { _Pragma("unroll") for (int i = 0; i < 2; ++i) { const int c = tid + 512 * i, row = c >> 3, cc = c & 7; \
        ATT_LAS u32x2* p = (ATT_LAS u32x2*)(lds + LDS_V + row * VROW + cc * 16); p[0] = (u32x2){vreg[i].x, vreg[i].y}; p[1] = (u32x2){vreg[i].z, vreg[i].w}; } } while (0)
#define ATT_SCORES(kt, hh) do { \
        _Pragma("unroll") for (int c = 0; c < NMAP; ++c) { f32x16 a = {}; \
            _Pragma("unroll") for (int dc = 0; dc < NDC; ++dc) { const bf16x8 kf = *(const ATT_LAS bf16x8*)(lds + LDS_K + (32 * (hh) + r) * KROW + (c * DQK + 16 * dc + 8 * h) * 2); \
                a = __builtin_amdgcn_mfma_f32_32x32x16_bf16(kf, qf[c][dc], a, 0, 0, 0); } \
            s[c] = a; } \
        _Pragma("unroll") for (int i = 0; i < 16; ++i) { \
            const int rel = (kt) * 64 + 32 * (hh) + (i & 3) + 8 * (i >> 2) + 4 * h - qpos; float b = 0.f; \
            if (BIAS) { int ix = rel < -128 ? -128 : (rel > 128 ? 128 : rel); b = tab[ix + 128]; } \
            const bool ok = !WIN || (rel >= -128 && rel <= 128); \
            _Pragma("unroll") for (int c = 0; c < NMAP; ++c) { const float v = s[c][i] * D.sc2 + b; s[c][i] = ok ? v : NEGBIG; } } } while (0)
    const bool wave_all = !WIN;
#define ATT_ACTIVE(kt) (wave_all || ((kt) * 64 + 63 >= D.qpos0 - 128 && (kt) * 64 <= D.qpos0 + 31 + 128))

    float m[NMAP], l[NMAP];
#pragma unroll
    for (int c = 0; c < NMAP; ++c) { m[c] = (WIN && h == 0) ? D.sink2 : NEGBIG; l[c] = (WIN && h == 0) ? 1.f : 0.f; }
    f32x16 s[NMAP];
    ATT_LOADK(D.kt0);
    for (int kt = D.kt0; kt < D.kt1; ++kt) {
        ATT_STOREK(); __syncthreads();
        if (kt + 1 < D.kt1) ATT_LOADK(kt + 1);
        if (ATT_ACTIVE(kt)) {
#pragma unroll
            for (int hh = 0; hh < 2; ++hh) {
                ATT_SCORES(kt, hh);
#pragma unroll
                for (int c = 0; c < NMAP; ++c) {
                    float tm = s[c][0];
#pragma unroll
                    for (int i = 1; i < 16; ++i) tm = fmaxf(tm, s[c][i]);
                    const float mn = fmaxf(m[c], tm); float sum = 0.f;
#pragma unroll
                    for (int i = 0; i < 16; ++i) sum += __builtin_amdgcn_exp2f(s[c][i] - mn);
                    l[c] = l[c] * __builtin_amdgcn_exp2f(m[c] - mn) + sum; m[c] = mn;
                }
            }
        }
        __syncthreads();
    }
    float coef[NMAP];
#pragma unroll
    for (int c = 0; c < NMAP; ++c) {
        const float mo = __shfl_xor(m[c], 32), lo = __shfl_xor(l[c], 32); const float M = fmaxf(m[c], mo);
        const float L = l[c] * __builtin_amdgcn_exp2f(m[c] - M) + lo * __builtin_amdgcn_exp2f(mo - M);
        m[c] = M; coef[c] = 1.0f / L;
    }
    if (NMAP == 2) coef[NMAP - 1] = -D.lam * coef[NMAP - 1];
    f32x16 o[4];
#pragma unroll
    for (int db = 0; db < 4; ++db) o[db] = (f32x16){};
    ATT_LOADK(D.kt0); ATT_LOADV(D.kt0);
    for (int kt = D.kt0; kt < D.kt1; ++kt) {
        ATT_STOREK(); ATT_STOREV(); __syncthreads();
        if (kt + 1 < D.kt1) { ATT_LOADK(kt + 1); ATT_LOADV(kt + 1); }
        if (ATT_ACTIVE(kt)) {
#pragma unroll
            for (int hh = 0; hh < 2; ++hh) {
                ATT_SCORES(kt, hh);
                float p[16];
#pragma unroll
                for (int i = 0; i < 16; ++i) { float a = 0.f;
#pragma unroll
                    for (int c = 0; c < NMAP; ++c) a += __builtin_amdgcn_exp2f(s[c][i] - m[c]) * coef[c];
                    p[i] = a; }
#pragma unroll
                for (int ks = 0; ks < 2; ++ks) {
                    u32x4 pw; pw.x = pk_bf16(p[8 * ks + 0], p[8 * ks + 1]); pw.y = pk_bf16(p[8 * ks + 2], p[8 * ks + 3]); pw.z = pk_bf16(p[8 * ks + 4], p[8 * ks + 5]); pw.w = pk_bf16(p[8 * ks + 6], p[8 * ks + 7]);
                    const bf16x8 pf = __builtin_bit_cast(bf16x8, pw);
#pragma unroll
                    for (int db = 0; db < 4; ++db) {
                        const ATT_LAS u32x2* vp = (const ATT_LAS u32x2*)(lds + LDS_V + (32 * db + r) * VROW + (32 * hh + 16 * ks + 4 * h) * 2);
                        const u32x2 v0 = vp[0], v1 = vp[2];
                        const bf16x8 vf = __builtin_bit_cast(bf16x8, (u32x4){v0.x, v0.y, v1.x, v1.y});
                        o[db] = __builtin_amdgcn_mfma_f32_32x32x16_bf16(pf, vf, o[db], 0, 0, 0);
                    }
                }
            }
        }
        __syncthreads();
    }
    if (SUBLN) {
        float gain[4];
#pragma unroll
        for (int db = 0; db < 4; ++db) gain[db] = D.subg[32 * db + r] * 0.8f;
#pragma unroll
        for (int i = 0; i < 16; ++i) {
            float ss = 0.f;
#pragma unroll
            for (int db = 0; db < 4; ++db) ss += o[db][i] * o[db][i];
            ss += __shfl_xor(ss, 1); ss += __shfl_xor(ss, 2); ss += __shfl_xor(ss, 4); ss += __shfl_xor(ss, 8); ss += __shfl_xor(ss, 16);
            const float rs = 1.0f / sqrtf(ss * (1.0f / 128.0f) + 1e-5f);
#pragma unroll
            for (int db = 0; db < 4; ++db) o[db][i] = o[db][i] * rs * gain[db];
        }
    }
#pragma unroll
    for (int i = 0; i < 16; ++i) { const int q = (i & 3) + 8 * (i >> 2) + 4 * h; bf16_t* orow = D.Ow + (size_t)q * D.ldo + r;
#pragma unroll
        for (int db = 0; db < 4; ++db) orow[32 * db] = (bf16_t)(pk_bf16(o[db][i], 0.f) & 0xffffu); }
#undef ATT_LOADK
#undef ATT_STOREK
#undef ATT_LOADV
#undef ATT_STOREV
#undef ATT_SCORES
#undef ATT_ACTIVE
}
}
constexpr int NWAVES = 8;
#ifndef MK_N_LAUNCHES
#define MK_N_LAUNCHES 1
#endif
constexpr int N_PHASES = 10;
constexpr int N_LAUNCHES = MK_N_LAUNCHES;

constexpr int BATCH = 4, SEQ = 2048, D = 2048, T = BATCH * SEQ, NMEM = 256, TM = BATCH * NMEM;
constexpr int IN_W = 5632, NQK = 4352, NV = 1280, NG = 6144, DFF = 5504, NUP = 2 * DFF, NBR = 3072;
constexpr float LN_EPS = 1e-5f;
constexpr float ALPHA = 1.189207115002721f;
constexpr int C_DQ = 0, C_DK = 1024, C_WQ = 2048, C_WK = 3072, C_MQ = 3328;

constexpr size_t MiB = 1u << 20;
constexpr size_t WS_CTL = 0, CTL_ZERO_BYTES = 64 * 1024;
constexpr size_t WS_WBR = 1 * MiB;
constexpr size_t WS_WO = 13 * MiB;
constexpr size_t WS_WINQK = 21 * MiB;
constexpr size_t WS_WINV = 38 * MiB;
constexpr size_t WS_WGATE = 43 * MiB;
constexpr size_t WS_WMEM = 67 * MiB;
constexpr size_t WS_H0B = 75 * MiB;
constexpr size_t WS_MEMB = 107 * MiB;
constexpr size_t WS_QKP = 111 * MiB;
constexpr size_t WS_VT = 179 * MiB;
constexpr size_t WS_MK = 199 * MiB;
constexpr size_t WS_MVT = 201 * MiB;
constexpr size_t WS_GATES = 203 * MiB;
constexpr size_t WS_BR = 299 * MiB;
constexpr size_t WS_MIXED = 21 * MiB;
constexpr size_t WS_H1B = 53 * MiB;
constexpr size_t WS_WUP = 111 * MiB;
constexpr size_t WS_WDOWN = 154 * MiB;
constexpr size_t WS_U = 176 * MiB;
constexpr size_t WS_ACT = 21 * MiB;
constexpr size_t WS_END = 348 * MiB;
constexpr int CW_BAR = 1024;

constexpr int RING_BYTES = 131072, LDSCTL_OFF = RING_BYTES, MISC_OFF = LDSCTL_OFF + 320, LDS_BYTES = 147456;

#define GAS __attribute__((address_space(1)))
#define LAS __attribute__((address_space(3)))
typedef unsigned short bf16;
typedef unsigned v4u __attribute__((ext_vector_type(4)));
typedef unsigned v2u __attribute__((ext_vector_type(2)));
typedef float f32x4 __attribute__((ext_vector_type(4)));
#define LDS_WAIT() asm volatile("s_waitcnt lgkmcnt(0)" ::: "memory")
__device__ __forceinline__ unsigned f2bf(float f) { unsigned u = __builtin_bit_cast(unsigned, f); return (u + 0x7fffu + ((u >> 16) & 1u)) >> 16; }
__device__ __forceinline__ unsigned pk2(float lo, float hi) { return f2bf(lo) | (f2bf(hi) << 16); }
__device__ __forceinline__ float bflo(unsigned w) { return __uint_as_float(w << 16); }
__device__ __forceinline__ float bfhi(unsigned w) { return __uint_as_float(w & 0xffff0000u); }

#define XB_TMO      128
#define XB_XCNT(j)  (256  + 64 * (j))
#define XB_XSUB(j)  (1280 + 64 * (j))
#define XB_XGEN(j)  (2304 + 64 * (j))
#define XB_TOP      3328
#define XB_TOPGEN   3392
#define XCD_BAR_WORDS 3456
#define XB_SPIN_CAP (1u << 20)
__device__ __forceinline__ unsigned xb_ld(unsigned* p)              { return __hip_atomic_load(p, __ATOMIC_RELAXED, __HIP_MEMORY_SCOPE_AGENT); }
__device__ __forceinline__ unsigned xb_add(unsigned* p, unsigned v) { return __hip_atomic_fetch_add(p, v, __ATOMIC_RELAXED, __HIP_MEMORY_SCOPE_AGENT); }
__device__ __forceinline__ unsigned xb_xcc_id() { return (unsigned)__builtin_amdgcn_s_getreg((3 << 11) | 20) & 0xFu; }
#define XB_SPIN(cond, bar) do { unsigned _sp = 0; while (cond) { __builtin_amdgcn_s_sleep(1); \
    if ((++_sp & 255u) == 0u) { if (xb_ld(&(bar)[XB_TMO])) break; if (_sp > XB_SPIN_CAP) { atomicAdd(&(bar)[XB_TMO], 1u); break; } } } } while (0)
struct XcdBarrier { unsigned* bar; unsigned x; volatile LAS unsigned* st; };
__device__ __forceinline__ XcdBarrier xcd_barrier_post(unsigned* bar, volatile LAS unsigned* st) {
    XcdBarrier b; b.bar = bar; b.x = xb_xcc_id(); b.st = st;
    if (threadIdx.x == 0) (void)xb_add(&bar[XB_XCNT(b.x)], 1u);
    return b;
}
__device__ __forceinline__ void xcd_barrier_complete(unsigned* bar, unsigned x, unsigned& nloc, unsigned& nx) {
    const unsigned G = gridDim.x * gridDim.y * gridDim.z;
    unsigned sum, cnt, mine, sp = 0u;
    for (;;) {
        sum = 0u; cnt = 0u; mine = 0u;
#pragma unroll
        for (unsigned j = 0; j < 16; ++j) { const unsigned c = xb_ld(&bar[XB_XCNT(j)]); sum += c; cnt += (c > 0u) ? 1u : 0u; mine = (j == x) ? c : mine; }
        if (sum == G) break;
        __builtin_amdgcn_s_sleep(1);
        if ((++sp & 255u) == 0u) { if (xb_ld(&bar[XB_TMO])) break; if (sp > XB_SPIN_CAP) { atomicAdd(&bar[XB_TMO], 1u); break; } }
    }
    nloc = mine > 0u ? mine : 1u; nx = cnt > 0u ? cnt : 1u;
}
__device__ __forceinline__ void xcd_barrier(const XcdBarrier& b) {
    asm volatile("s_waitcnt vmcnt(0)" ::: "memory");
    __syncthreads();
    if (threadIdx.x == 0) {
        unsigned* bar = b.bar;
        __builtin_amdgcn_s_waitcnt(0);
        unsigned nloc = b.st[0], nx = b.st[1];
        if (nloc == 0u) { xcd_barrier_complete(bar, b.x, nloc, nx); b.st[0] = nloc; b.st[1] = nx; }
        const unsigned old = xb_add(&bar[XB_XSUB(b.x)], 1u);
        const unsigned gen = old / nloc;
        if (old + 1u == (gen + 1u) * nloc) {
            __builtin_amdgcn_fence(__ATOMIC_RELEASE, "agent");
            asm volatile("s_waitcnt vmcnt(0)" ::: "memory");
            const unsigned og = xb_add(&bar[XB_TOP], 1u);
            const unsigned tg = og / nx;
            if (og + 1u == (tg + 1u) * nx) xb_add(&bar[XB_TOPGEN], 1u);
            else XB_SPIN(xb_ld(&bar[XB_TOPGEN]) == tg, bar);
            __builtin_amdgcn_fence(__ATOMIC_ACQUIRE, "agent");
            xb_add(&bar[XB_XGEN(b.x)], 1u);
            asm volatile("s_waitcnt vmcnt(0)" ::: "memory");
        } else {
            XB_SPIN(xb_ld(&bar[XB_XGEN(b.x)]) == gen, bar);
            __builtin_amdgcn_fence(__ATOMIC_ACQUIRE, "agent");
            asm volatile("s_waitcnt vmcnt(0)" ::: "memory");
        }
    }
    __syncthreads();
}

__device__ __forceinline__ float wave_sum(float v) {
#pragma unroll
    for (int o = 1; o < 64; o <<= 1) v += __shfl_xor(v, o);
    return v;
}
__device__ __forceinline__ void transpose_item(const float* W, int ldw, int K, int ncols, bf16* WT, int ldt, int item, int lane) {
    const int nblk = ncols / 64, kb = item / nblk, nb = item % nblk, k0 = 64 * kb + 16 * (lane >> 4), n0 = 64 * nb + 4 * (lane & 15);
    const GAS float* src = (const GAS float*)W + (size_t)k0 * ldw + n0;
    f32x4 v[16];
#pragma unroll
    for (int i = 0; i < 16; ++i) v[i] = *(const GAS f32x4*)(src + (size_t)i * ldw);
#pragma unroll
    for (int j = 0; j < 4; ++j) {
        GAS v4u* dst = (GAS v4u*)(WT + (size_t)(n0 + j) * ldt + k0);
        v4u o0, o1;
        o0.x = pk2(v[0][j], v[1][j]); o0.y = pk2(v[2][j], v[3][j]); o0.z = pk2(v[4][j], v[5][j]); o0.w = pk2(v[6][j], v[7][j]);
        o1.x = pk2(v[8][j], v[9][j]); o1.y = pk2(v[10][j], v[11][j]); o1.z = pk2(v[12][j], v[13][j]); o1.w = pk2(v[14][j], v[15][j]);
        dst[0] = o0; dst[1] = o1;
    }
}
__device__ __forceinline__ void ln_row(const float* xrow, const float* g, const float* b, float* orow, bf16* brow, int lane) {
    const GAS f32x4* xr = (const GAS f32x4*)xrow + lane;
    f32x4 v[8]; float s = 0.f;
#pragma unroll
    for (int j = 0; j < 8; ++j) { v[j] = xr[64 * j]; s += (v[j].x + v[j].y) + (v[j].z + v[j].w); }
    const float mean = wave_sum(s) * (1.f / D); float s2 = 0.f;
#pragma unroll
    for (int j = 0; j < 8; ++j) { v[j] = v[j] - mean; s2 += (v[j].x * v[j].x + v[j].y * v[j].y) + (v[j].z * v[j].z + v[j].w * v[j].w); }
    const float rstd = 1.f / sqrtf(wave_sum(s2) * (1.f / D) + LN_EPS);
#pragma unroll
    for (int j = 0; j < 8; ++j) {
        const f32x4 gg = ((const GAS f32x4*)g)[lane + 64 * j], bb = ((const GAS f32x4*)b)[lane + 64 * j];
        const f32x4 y = v[j] * rstd * gg + bb;
        if (orow) ((GAS f32x4*)orow)[lane + 64 * j] = y;
        if (brow) ((GAS v2u*)brow)[lane + 64 * j] = (v2u){pk2(y.x, y.y), pk2(y.z, y.w)};
    }
}
__device__ __forceinline__ float gelu_tanh(float x) {
    const float z = 1.5957691216057308f * (x + 0.044715f * x * x * x);
    return x * __builtin_amdgcn_rcpf(1.0f + __builtin_amdgcn_exp2f(-1.4426950408889634f * z));
}
struct Args { const float* in[25]; float* out; unsigned char* ws; int ph_lo, ph_hi; };
enum { I_X = 0, I_MEM, I_LNG, I_LNB, I_REL, I_WIN, I_WMEM, I_LQ1, I_LK1, I_LQ2, I_LK2, I_SUBG, I_SINK, I_WGATE, I_BGATE, I_WBR, I_WO, I_LN1G, I_LN1B, I_WUP, I_CONVW, I_CONVB, I_WDOWN, I_LN2G, I_LN2B };

__device__ __forceinline__ void phase_attention(LAS unsigned char* lds, const Args& args, const bf16* QKP, const bf16* VT, const bf16* MK, const bf16* MVT, bf16* BR, int vcu, int G, int wave, int lane) {
        const float* rel_table = args.in[I_REL];
        float lam;
        { const float s1 = wave_sum(args.in[I_LQ1][lane] * args.in[I_LK1][lane]), s2 = wave_sum(args.in[I_LQ2][lane] * args.in[I_LK2][lane]); lam = expf(s1) - expf(s2) + 0.2f; }
        for (int u = vcu; u < 256; u += G) {
            const int b = u >> 6, h = (u >> 3) & 7, qb = u & 7;
            att::fill_bias(lds, 0, rel_table, h); __syncthreads();
            att::Desc d; const size_t row0 = (size_t)b * SEQ + qb * 256 + wave * 32;
            d.Qw = QKP + row0 * NQK + C_DQ + h * 128; d.ldq = NQK; d.K = QKP + (size_t)b * SEQ * NQK + C_DK + h * 128; d.ldk = NQK;
            d.Vt = VT + (size_t)(h * 128) * T + (size_t)b * SEQ; d.ldv = T; d.Ow = BR + row0 * NBR + h * 128; d.ldo = NBR;
            d.qpos0 = qb * 256 + wave * 32; d.kt0 = 0; d.kt1 = SEQ / 64; d.btab = 0; d.sc2 = 0.125f * att::LOG2E; d.sink2 = 0.f; d.lam = lam; d.subg = args.in[I_SUBG];
            att::attn_unit<2, 64, true, false, true>(lds, d);
        }
        for (int u = vcu; u < 256; u += G) {
            const int b = u >> 6, kvh = (u >> 5) & 1, qb = (u >> 1) & 15, pair = u & 1; const int qh = kvh * 4 + pair * 2 + (wave >> 2), qsub = wave & 3;
            att::fill_bias(lds, 0, rel_table, 8 + kvh * 4 + pair * 2); att::fill_bias(lds, 1, rel_table, 8 + kvh * 4 + pair * 2 + 1); __syncthreads();
            att::Desc d; const size_t row0 = (size_t)b * SEQ + qb * 128 + qsub * 32;
            d.Qw = QKP + row0 * NQK + C_WQ + qh * 128; d.ldq = NQK; d.K = QKP + (size_t)b * SEQ * NQK + C_WK + kvh * 128; d.ldk = NQK;
            d.Vt = VT + (size_t)(1024 + kvh * 128) * T + (size_t)b * SEQ; d.ldv = T; d.Ow = BR + row0 * NBR + 1024 + qh * 128; d.ldo = NBR;
            d.qpos0 = qb * 128 + qsub * 32; d.kt0 = (2 * qb - 2) < 0 ? 0 : (2 * qb - 2); d.kt1 = (2 * qb + 4) > SEQ / 64 ? SEQ / 64 : (2 * qb + 4);
            d.btab = wave >> 2; d.sc2 = 0.08838834764831845f * att::LOG2E; d.sink2 = args.in[I_SINK][qh] * att::LOG2E; d.lam = 0.f; d.subg = nullptr;
            att::attn_unit<1, 128, true, true, false>(lds, d);
        }
        for (int u = vcu; u < 256; u += G) {
            const int b = u >> 6, h = (u >> 4) & 3, qb = (u >> 1) & 7, half = u & 1;
            att::Desc d; const size_t row0 = (size_t)b * SEQ + qb * 256 + wave * 32;
            d.Qw = QKP + row0 * NQK + C_MQ + h * 256; d.ldq = NQK; d.K = MK + (size_t)(b * NMEM) * 1024 + h * 256; d.ldk = 1024;
            d.Vt = MVT + (size_t)(h * 256 + half * 128) * TM + b * NMEM; d.ldv = TM; d.Ow = BR + row0 * NBR + 2048 + h * 256 + half * 128; d.ldo = NBR;
            d.qpos0 = 0; d.kt0 = 0; d.kt1 = NMEM / 64; d.btab = 0; d.sc2 = 0.0625f * att::LOG2E; d.sink2 = 0.f; d.lam = 0.f; d.subg = nullptr;
            att::attn_unit<1, 256, false, false, false>(lds, d);
        }
}

__global__ void __launch_bounds__(NWAVES * 64, 2) mega_fwd(Args args) {
    extern __shared__ __attribute__((aligned(16))) unsigned char lds_raw[];
    LAS unsigned char* lds = (LAS unsigned char*)lds_raw;
    volatile LAS unsigned* MISC = (volatile LAS unsigned*)(lds + MISC_OFF);
    const int tid = threadIdx.x, lane = tid & 63, wave = __builtin_amdgcn_readfirstlane(tid >> 6);
    const int G = gridDim.x, bx = blockIdx.x;
    const int vcu = (G % 8 == 0) ? (bx % 8) * (G / 8) + bx / 8 : bx;
    unsigned char* ws = args.ws;
    for (int u = tid; u < (LDS_BYTES - LDSCTL_OFF) / 4; u += NWAVES * 64) ((LAS unsigned*)(lds + LDSCTL_OFF))[u] = 0u;
    __syncthreads();
    XcdBarrier bar; bar.bar = (unsigned*)(ws + WS_CTL) + CW_BAR; bar.x = 0; bar.st = nullptr;
    if (N_LAUNCHES == 1) bar = xcd_barrier_post((unsigned*)(ws + WS_CTL) + CW_BAR, MISC + 8);
#define GRID_BAR() do { if (N_LAUNCHES == 1) xcd_barrier(bar); } while (0)
#ifdef PROBE_TS
    unsigned long long* const ts_ = (unsigned long long*)(ws + 32768);
#define STAMP(k) do { if (bx == 0 && tid == 0) ts_[k] = __builtin_amdgcn_s_memrealtime(); } while (0)
    STAMP(0);
#else
#define STAMP(k) do {} while (0)
#endif
    const int lo = args.ph_lo, hi = args.ph_hi;
#define IN(k) (lo <= (k) && (k) < hi)
    float* out = args.out;
    bf16* const Wbr_t = (bf16*)(ws + WS_WBR); bf16* const Wo_t = (bf16*)(ws + WS_WO); bf16* const WinQK_t = (bf16*)(ws + WS_WINQK); bf16* const WinV_t = (bf16*)(ws + WS_WINV);
    bf16* const Wgate_t = (bf16*)(ws + WS_WGATE); bf16* const Wmem_t = (bf16*)(ws + WS_WMEM); bf16* const H0b = (bf16*)(ws + WS_H0B); bf16* const MEMb = (bf16*)(ws + WS_MEMB);
    bf16* const QKP = (bf16*)(ws + WS_QKP); bf16* const VT = (bf16*)(ws + WS_VT); bf16* const MK = (bf16*)(ws + WS_MK); bf16* const MVT = (bf16*)(ws + WS_MVT);
    bf16* const GATES = (bf16*)(ws + WS_GATES); bf16* const BR = (bf16*)(ws + WS_BR); bf16* const MIXED = (bf16*)(ws + WS_MIXED);
    bf16* const H1b = (bf16*)(ws + WS_H1B); bf16* const Wup_t = (bf16*)(ws + WS_WUP); bf16* const Wdown_t = (bf16*)(ws + WS_WDOWN); bf16* const U = (bf16*)(ws + WS_U); bf16* const ACT = (bf16*)(ws + WS_ACT);
    const int gw = vcu * NWAVES + wave, NGW = G * NWAVES;
#define TJOBP(src, ldw, K, ncols, dst, ldt) { const int n_ = ((K) / 64) * ((ncols) / 64); if (r < n_) { transpose_item((src), (ldw), (K), (ncols), (dst), (ldt), r, lane); continue; } r -= n_; }
#define TJOB(src, ldw, K, ncols, dst) { const int n_ = ((K) / 64) * ((ncols) / 64); if (r < n_) { transpose_item((src), (ldw), (K), (ncols), (dst), (K), r, lane); continue; } r -= n_; }

    if (IN(0)) {
        const float* w_in = args.in[I_WIN];
        constexpr int I1 = 32 * 16, I2 = 32 * 4;
        constexpr int NIT = 5 * I1 + 2 * I2 + 32 * (NG / 64) + 32 * 32 + 3 * (16 * 32) + 32 * 32;
        for (int it = gw; it < NIT; it += NGW) {
            int r = it;
            TJOB(w_in + 0, IN_W, 2048, 1024, WinQK_t + (size_t)C_DQ * 2048)
            TJOB(w_in + 1024, IN_W, 2048, 1024, WinQK_t + (size_t)C_DK * 2048)
            TJOB(w_in + 2048, IN_W, 2048, 1024, WinV_t)
            TJOB(w_in + 3072, IN_W, 2048, 1024, WinQK_t + (size_t)C_WQ * 2048)
            TJOB(w_in + 4096, IN_W, 2048, 256, WinQK_t + (size_t)C_WK * 2048)
            TJOB(w_in + 4352, IN_W, 2048, 256, WinV_t + (size_t)1024 * 2048)
            TJOB(w_in + 4608, IN_W, 2048, 1024, WinQK_t + (size_t)C_MQ * 2048)
            TJOB(args.in[I_WGATE], NG, 2048, NG, Wgate_t)
            TJOB(args.in[I_WMEM], 2048, 2048, 2048, Wmem_t)
            TJOBP(args.in[I_WBR], 2048, 1024, 2048, Wbr_t, NBR)
            TJOBP(args.in[I_WBR] + (size_t)1024 * 2048, 2048, 1024, 2048, Wbr_t + 1024, NBR)
            TJOBP(args.in[I_WBR] + (size_t)2 * 1024 * 2048, 2048, 1024, 2048, Wbr_t + 2048, NBR)
            TJOB(args.in[I_WO], 2048, 2048, 2048, Wo_t)
        }
        for (int m = gw; m < T; m += NGW) ln_row(args.in[I_X] + (size_t)m * D, args.in[I_LNG], args.in[I_LNB], out + (size_t)m * D, H0b + (size_t)m * D, lane);
        for (int m = gw; m < TM; m += NGW) { const GAS f32x4* xr = (const GAS f32x4*)(args.in[I_MEM] + (size_t)m * D) + lane; GAS v2u* o = (GAS v2u*)(MEMb + (size_t)m * D) + lane;
#pragma unroll
            for (int j = 0; j < 8; ++j) { const f32x4 v = xr[64 * j]; o[64 * j] = (v2u){pk2(v.x, v.y), pk2(v.z, v.w)}; } }
        if (IN(1)) GRID_BAR();
        STAMP(1);
    }

    if (IN(1)) {
        pg8::Gemm g{nullptr, nullptr, 2048, 2048, 0, 0, 2048};
        pg8::MultiOrder S; S.G = G; S.c = bx;
        S.nM0 = T / 256;  S.nN0 = NG / 256;
        S.nM1 = T / 256;  S.nN1 = NQK / 256;
        S.nM2 = NV / 256; S.nN2 = T / 256;
        S.nM3 = TM / 256; S.nN3 = 1024 / 256;
        S.nM4 = 1024 / 256; S.nN4 = TM / 256;
        S.total = S.nM0 * S.nN0 + S.nM1 * S.nN1 + S.nM2 * S.nN2 + S.nM3 * S.nN3 + S.nM4 * S.nN4;
        pg8::MultiPtrs P{H0b, Wgate_t, H0b, WinQK_t, WinV_t, H0b, MEMb, Wmem_t, Wmem_t + (size_t)1024 * 2048, MEMb};
        pg8::EpiBf16Multi E{pg8::EpiBf16{GATES, NG, args.in[I_BGATE], 2}, pg8::EpiBf16{QKP, NQK, nullptr, 0}, pg8::EpiBf16{VT, T, nullptr, 0}, pg8::EpiBf16{MK, 1024, nullptr, 0}, pg8::EpiBf16{MVT, TM, nullptr, 0}};
        pg8::gemm_phase<pg8::EpiBf16Multi, pg8::MultiOrder, pg8::MultiPtrs>(lds, g, S, P, E);
        if (IN(2)) GRID_BAR();
        STAMP(2);
    }

    if (IN(2)) {
        phase_attention(lds, args, QKP, VT, MK, MVT, BR, vcu, G, wave, lane);
        if (IN(3)) GRID_BAR();
        STAMP(3);
    }

    if (IN(3)) {
        pg8::Gemm g{BR, Wbr_t, NBR, NBR, T, D, NBR};
        pg8::EpiGate E{GATES, NG, MIXED, D};
        pg8::StaticOrder S; S.init(T, D, G, bx); pg8::SinglePtrs P{g.A, g.Bt};
        pg8::gemm_phase<pg8::EpiGate, pg8::StaticOrder, pg8::SinglePtrs>(lds, g, S, P, E);
        if (IN(4)) GRID_BAR();
        STAMP(4);
    }

    if (IN(4)) {
        pg8::Gemm g{MIXED, Wo_t, 2048, 2048, T, D, 2048}; pg8::EpiResid E{out, D, ALPHA};
        pg8::StaticOrder S; S.init(T, D, G, bx); pg8::SinglePtrs P{g.A, g.Bt};
        pg8::gemm_phase<pg8::EpiResid, pg8::StaticOrder, pg8::SinglePtrs>(lds, g, S, P, E);
        if (IN(5)) GRID_BAR();
        STAMP(5);
    }

    if (IN(5)) {
        for (int m = gw; m < T; m += NGW) ln_row(out + (size_t)m * D, args.in[I_LN1G], args.in[I_LN1B], out + (size_t)m * D, H1b + (size_t)m * D, lane);
        constexpr int NIT = 32 * (NUP / 64) + (DFF / 64) * 32;
        for (int it = gw; it < NIT; it += NGW) {
            int r = it;
            TJOB(args.in[I_WUP], NUP, 2048, NUP, Wup_t)
            TJOB(args.in[I_WDOWN], 2048, DFF, 2048, Wdown_t)
        }
        if (IN(6)) GRID_BAR();
        STAMP(6);
    }

    if (IN(6)) {
        pg8::Gemm g{H1b, Wup_t, 2048, 2048, T, NUP, 2048}; pg8::EpiBf16 E; E.O = U; E.ldc = NUP; E.bias = nullptr; E.act = 0;
        pg8::StaticOrder S; S.init(T, NUP, G, bx); pg8::SinglePtrs P{g.A, g.Bt};
        pg8::gemm_phase<pg8::EpiBf16, pg8::StaticOrder, pg8::SinglePtrs>(lds, g, S, P, E);
        if (IN(7)) GRID_BAR();
        STAMP(7);
    }

    if (IN(7)) {
        const float* cw = args.in[I_CONVW]; const float* cb = args.in[I_CONVB];
        constexpr int NCH = DFF / 8, RUN = 8, NITEM = (T / RUN) * NCH;
        for (int item = bx * (NWAVES * 64) + tid; item < NITEM; item += G * NWAVES * 64) {
            const int tr = item / NCH, c = item % NCH, t0 = tr * RUN, n0 = c * 8;
            v4u ra[RUN + 2], rb[RUN + 2];
#pragma unroll
            for (int i = 0; i < RUN + 2; ++i) {
                const int t = t0 - 1 + i; const bool zero = (i == 0 && (t0 % SEQ) == 0) || (i == RUN + 1 && ((t0 + RUN) % SEQ) == 0);
                if (zero) { ra[i] = (v4u){0u, 0u, 0u, 0u}; rb[i] = (v4u){0u, 0u, 0u, 0u}; }
                else { ra[i] = *(const GAS v4u*)(U + (size_t)t * NUP + n0); rb[i] = *(const GAS v4u*)(U + (size_t)t * NUP + DFF + n0); }
            }
            float w0[16], w1[16], w2[16], bb[16];
#pragma unroll
            for (int e = 0; e < 8; ++e) { w0[e] = cw[n0 + e]; w1[e] = cw[NUP + n0 + e]; w2[e] = cw[2 * NUP + n0 + e]; bb[e] = cb[n0 + e];
                w0[8 + e] = cw[DFF + n0 + e]; w1[8 + e] = cw[NUP + DFF + n0 + e]; w2[8 + e] = cw[2 * NUP + DFF + n0 + e]; bb[8 + e] = cb[DFF + n0 + e]; }
#define UNPK(dst, a_, b_) do { dst[0] = bflo(a_.x); dst[1] = bfhi(a_.x); dst[2] = bflo(a_.y); dst[3] = bfhi(a_.y); dst[4] = bflo(a_.z); dst[5] = bfhi(a_.z); dst[6] = bflo(a_.w); dst[7] = bfhi(a_.w); \
                dst[8] = bflo(b_.x); dst[9] = bfhi(b_.x); dst[10] = bflo(b_.y); dst[11] = bfhi(b_.y); dst[12] = bflo(b_.z); dst[13] = bfhi(b_.z); dst[14] = bflo(b_.w); dst[15] = bfhi(b_.w); } while (0)
#pragma unroll
            for (int tt = 0; tt < RUN; ++tt) {
                float prev[16], cur[16], nxt[16];
                UNPK(prev, ra[tt], rb[tt]); UNPK(cur, ra[tt + 1], rb[tt + 1]); UNPK(nxt, ra[tt + 2], rb[tt + 2]);
                float o[8];
#pragma unroll
                for (int e = 0; e < 8; ++e) { const float val = prev[e] * w0[e] + cur[e] * w1[e] + nxt[e] * w2[e] + bb[e];
                    const float gt = prev[8 + e] * w0[8 + e] + cur[8 + e] * w1[8 + e] + nxt[8 + e] * w2[8 + e] + bb[8 + e]; o[e] = gelu_tanh(gt) * val; }
                *(GAS v4u*)(ACT + (size_t)(t0 + tt) * DFF + n0) = (v4u){pk2(o[0], o[1]), pk2(o[2], o[3]), pk2(o[4], o[5]), pk2(o[6], o[7])};
            }
#undef UNPK
        }
        if (IN(8)) GRID_BAR();
        STAMP(8);
    }

    if (IN(8)) {
        pg8::Gemm g{ACT, Wdown_t, DFF, DFF, T, D, DFF}; pg8::EpiResid E{out, D, ALPHA};
        pg8::StaticOrder S; S.init(T, D, G, bx); pg8::SinglePtrs P{g.A, g.Bt};
        pg8::gemm_phase<pg8::EpiResid, pg8::StaticOrder, pg8::SinglePtrs>(lds, g, S, P, E);
        if (IN(9)) GRID_BAR();
        STAMP(9);
    }

    if (IN(9)) {
        for (int m = gw; m < T; m += NGW) ln_row(out + (size_t)m * D, args.in[I_LN2G], args.in[I_LN2B], out + (size_t)m * D, nullptr, lane);
#ifdef PROBE_TS
        GRID_BAR(); STAMP(10);
        if (bx == 0 && tid == 0) {
            const unsigned long long* tsr = (const unsigned long long*)(ws + 32768);
            const unsigned long long da = tsr[PROBE_A + 1] - tsr[PROBE_A], db = tsr[PROBE_B + 1] - tsr[PROBE_B];
            const unsigned long long spin = 8ull * da + 8ull * db;
            const unsigned long long t0 = __builtin_amdgcn_s_memrealtime();
            while (__builtin_amdgcn_s_memrealtime() - t0 < spin) __builtin_amdgcn_s_sleep(8);
        }
#endif
    }
#undef IN
#undef TJOB
#undef TJOBP
#undef GRID_BAR
}

extern "C" void kernel_launch(void* const* d_in, const int* in_sizes, int n_in, void* d_out, int out_size, void* d_ws, size_t ws_size, hipStream_t stream) {
    static int grid = 0;
    if (grid == 0) {
        if (n_in != 25 || in_sizes[0] != T * D || out_size != T * D || ws_size < WS_END) { fprintf(stderr, "kernel_launch: unexpected shapes (n_in %d, in0 %d, out %d, ws %zu < %zu)\n", n_in, n_in > 0 ? in_sizes[0] : -1, out_size, ws_size, (size_t)WS_END); grid = -1; return; }
        int dev = 0, cus = 0, per_cu = 0;
        if (hipGetDevice(&dev) != hipSuccess || hipDeviceGetAttribute(&cus, hipDeviceAttributeMultiprocessorCount, dev) != hipSuccess) { fprintf(stderr, "kernel_launch: device query failed\n"); grid = -1; return; }
        if (hipFuncSetAttribute((const void*)mega_fwd, hipFuncAttributeMaxDynamicSharedMemorySize, LDS_BYTES) != hipSuccess) { fprintf(stderr, "kernel_launch: hipFuncSetAttribute failed\n"); grid = -1; return; }
        if (hipOccupancyMaxActiveBlocksPerMultiprocessor(&per_cu, (const void*)mega_fwd, NWAVES * 64, LDS_BYTES) != hipSuccess || per_cu < 1)
            fprintf(stderr, "kernel_launch: note: occupancy query reports %d workgroups per CU\n", per_cu);
        (void)hipGetLastError();
        grid = cus;
    }
    if (grid < 0) return;
    if (hipMemsetAsync((char*)d_ws + WS_CTL, 0, CTL_ZERO_BYTES, stream) != hipSuccess) { fprintf(stderr, "kernel_launch: memset failed\n"); return; }
    Args a{};
    for (int i = 0; i < 25; ++i) a.in[i] = (const float*)d_in[i];
    a.out = (float*)d_out; a.ws = (unsigned char*)d_ws;
    if (N_LAUNCHES == 1) { a.ph_lo = 0; a.ph_hi = N_PHASES; hipLaunchKernelGGL(mega_fwd, dim3(grid), dim3(NWAVES * 64), LDS_BYTES, stream, a); }
    else for (int li = 0; li < N_PHASES; ++li) { a.ph_lo = li; a.ph_hi = li + 1; hipLaunchKernelGGL(mega_fwd, dim3(grid), dim3(NWAVES * 64), LDS_BYTES, stream, a); }
    const hipError_t le = hipPeekAtLastError();
    if (le != hipSuccess) fprintf(stderr, "kernel_launch: launch failed: %s\n", hipGetErrorName(le));
}
```

```cpp
#include <hip/hip_runtime.h>
#include <cstdio>
#include <cstdint>
#include <cmath>
namespace pg8 {
#define PG8_LAS __attribute__((address_space(3)))
typedef unsigned short bf16_t;
typedef short bf16x8 __attribute__((ext_vector_type(8)));
typedef float f32x4 __attribute__((ext_vector_type(4)));
typedef float f32x2 __attribute__((ext_vector_type(2)));
typedef unsigned u32x4 __attribute__((ext_vector_type(4)));
typedef unsigned u32x2 __attribute__((ext_vector_type(2)));
constexpr int BM = 256, BK = 64, HALF = 128, HTB = HALF * BK * 2  , STAGE_BYTES = 8 * HTB, NXCD = 8, WGM = 8;

__host__ __device__ __forceinline__ int lds_byte(int r, int c) { const int st = (r >> 4) * 2 + (c >> 5), rr = r & 15, cc = c & 31, ob = rr * 64 + cc * 2; return st * 1024 + (ob ^ (((ob >> 9) & 1) << 5)); }
__host__ __device__ __forceinline__ void stage_rc(int b, int& R, int& C) { const int st = b / 1024, sb = b % 1024, swz = sb ^ (((sb >> 9) & 1) << 5); R = (st >> 1) * 16 + swz / 64; C = (st & 1) * 32 + (swz % 64) / 2; }
__host__ __device__ __forceinline__ int perm32(int rho) { const int n = rho >> 4, i = rho & 15; return 8 * (i >> 2) + 4 * n + (i & 3); }

struct Unit { int pm, pn, job; };
struct Gemm { const bf16_t* A; const bf16_t* Bt; int lda, ldb, M, N, K; };

struct StaticOrder {
    int nM, nN, nwg, G, c;
    __host__ __device__ void init(int M, int N, int G_, int c_) { nM = M / BM; nN = N / BM; nwg = nM * nN; G = G_; c = c_; }
    __host__ __device__ bool next(int i, Unit& u) const {
        const long L = (long)i * G + c; if (L >= nwg) return false;
        int wgid = (int)L; { const int q = nwg / NXCD, r = nwg % NXCD, xcd = wgid % NXCD, off = wgid / NXCD; wgid = (xcd < r ? xcd * (q + 1) : r * (q + 1) + (xcd - r) * q) + off; }
        const int nig = WGM * nN, gid = wgid / nig, fm = gid * WGM, gsz = (nM - fm) < WGM ? (nM - fm) : WGM;
        u.pm = fm + ((wgid % nig) % gsz); u.pn = (wgid % nig) / gsz; u.job = 0; return true;
    }
};
struct MultiOrder {
    int nM0, nN0, nM1, nN1, nM2, nN2, nM3, nN3, nM4, nN4, total, G, c;
    __host__ __device__ bool next(int i, Unit& u) const {
        const long L = (long)i * G + c; if (L >= total) return false;
        int wgid = (int)L; { const int q = total / NXCD, r = total % NXCD, xcd = wgid % NXCD, off = wgid / NXCD; wgid = (xcd < r ? xcd * (q + 1) : r * (q + 1) + (xcd - r) * q) + off; }
        int j = 0, m_ = nM0, n_ = nN0;
        if (wgid >= m_ * n_) { wgid -= m_ * n_; j = 1; m_ = nM1; n_ = nN1;
            if (wgid >= m_ * n_) { wgid -= m_ * n_; j = 2; m_ = nM2; n_ = nN2;
                if (wgid >= m_ * n_) { wgid -= m_ * n_; j = 3; m_ = nM3; n_ = nN3;
                    if (wgid >= m_ * n_) { wgid -= m_ * n_; j = 4; m_ = nM4; n_ = nN4; } } } }
        const int nig = WGM * n_, gid = wgid / nig, fm = gid * WGM, gsz = (m_ - fm) < WGM ? (m_ - fm) : WGM;
        u.pm = fm + ((wgid % nig) % gsz); u.pn = (wgid % nig) / gsz; u.job = j; return true;
    }
};

__device__ __forceinline__ unsigned cvt_pk_bf16(float lo, float hi) { unsigned r; asm volatile("v_cvt_pk_bf16_f32 %0, %1, %2" : "=v"(r) : "v"(lo), "v"(hi)); return r; }
__device__ __forceinline__ float bf_lo(unsigned w) { return __uint_as_float(w << 16); }
__device__ __forceinline__ float bf_hi(unsigned w) { return __uint_as_float(w & 0xffff0000u); }
__device__ __forceinline__ float sigmoidf_(float z) { return __builtin_amdgcn_rcpf(1.0f + __builtin_amdgcn_exp2f(-1.4426950408889634f * z)); }

struct EpiBf16 {
    static constexpr bool PERM = true, MIDK = false;
    bf16_t* O; int ldc; const float* bias; int act; float scl;
    __device__ __forceinline__ void operator()(const f32x4 (&acc)[2][2][4][2], const Unit& u, int wr, int wc, int fr, int fq) const {
        const int row0 = u.pm * BM + wr * 64 + fr; const int col0 = u.pn * BM + wc * 32 + 8 * fq;
        f32x4 bv[2][2];
#pragma unroll
        for (int bj = 0; bj < 2; ++bj)
#pragma unroll
            for (int n = 0; n < 2; ++n) bv[bj][n] = bias ? *(const f32x4*)(bias + col0 + bj * HALF + 4 * n) : (f32x4){0.f, 0.f, 0.f, 0.f};
#pragma unroll
        for (int ai = 0; ai < 2; ++ai)
#pragma unroll
            for (int m = 0; m < 4; ++m) { bf16_t* rowp = O + (size_t)(row0 + ai * HALF + m * 16) * ldc + col0;
#pragma unroll
                for (int bj = 0; bj < 2; ++bj) { f32x4 v0 = acc[ai][bj][m][0] + bv[bj][0], v1 = acc[ai][bj][m][1] + bv[bj][1];
                    if (act == 2) {
#pragma unroll
                        for (int e = 0; e < 4; ++e) { v0[e] = sigmoidf_(v0[e]); v1[e] = sigmoidf_(v1[e]); } }
                    v0 = v0 * scl; v1 = v1 * scl;
                    u32x4 w; w.x = cvt_pk_bf16(v0[0], v0[1]); w.y = cvt_pk_bf16(v0[2], v0[3]); w.z = cvt_pk_bf16(v1[0], v1[1]); w.w = cvt_pk_bf16(v1[2], v1[3]);
                    *(u32x4*)(rowp + bj * HALF) = w; } }
    }
};

struct EpiBf16Multi {
    static constexpr bool PERM = true, MIDK = false;
    EpiBf16 e0, e1, e2, e3, e4; float qs_diff, qs_win, qs_mem;
    __device__ __forceinline__ void operator()(const f32x4 (&acc)[2][2][4][2], const Unit& u, int wr, int wc, int fr, int fq) const {
        const int j = u.job; EpiBf16 x;
        x.O = j == 1 ? e1.O : j == 2 ? e2.O : j == 3 ? e3.O : j == 4 ? e4.O : e0.O;
        x.ldc = j == 1 ? e1.ldc : j == 2 ? e2.ldc : j == 3 ? e3.ldc : j == 4 ? e4.ldc : e0.ldc;
        x.bias = j == 1 ? e1.bias : j == 2 ? e2.bias : j == 3 ? e3.bias : j == 4 ? e4.bias : e0.bias;
        x.act = j == 1 ? e1.act : j == 2 ? e2.act : j == 3 ? e3.act : j == 4 ? e4.act : e0.act;
        x.scl = 1.0f;
        if (j == 1) { const int pn = u.pn; x.scl = pn < 4 ? qs_diff : (pn >= 8 && pn < 12) ? qs_win : pn >= 13 ? qs_mem : 1.0f; }
        x(acc, u, wr, wc, fr, fq);
    }
};

struct EpiGate {
    static constexpr bool PERM = true, MIDK = true;
    const bf16_t* G; int ldg; bf16_t* O; int ldo;
    __device__ __forceinline__ void mid(f32x4 (&acc)[2][2][4][2], const Unit& u, int seg  , int wr, int wc, int fr, int fq) const {
        const char* gbase = (const char*)G + (size_t)(seg - 1) * 4096;
        const unsigned off0 = (unsigned)((u.pm * BM + wr * 64 + fr) * ldg + u.pn * BM + wc * 32 + 8 * fq) * 2u, rstep = (unsigned)ldg * 32u;
#pragma unroll
        for (int ai = 0; ai < 2; ++ai)
#pragma unroll
            for (int m = 0; m < 4; ++m) { const unsigned off = off0 + (unsigned)(ai * 8 + m) * rstep;
                u32x4 ga[2], gb[2];
#pragma unroll
                for (int bj = 0; bj < 2; ++bj) { ga[bj] = *(const u32x4*)(gbase + off + bj * 256); gb[bj] = *(const u32x4*)(gbase + off + 4096 + bj * 256); }
#pragma unroll
                for (int bj = 0; bj < 2; ++bj)
#pragma unroll
                    for (int e = 0; e < 4; ++e) {
                        const float r0 = bf_lo(ga[bj][e]) * __builtin_amdgcn_rcpf(fmaxf(bf_lo(gb[bj][e]), 1e-30f)), r1 = bf_hi(ga[bj][e]) * __builtin_amdgcn_rcpf(fmaxf(bf_hi(gb[bj][e]), 1e-30f));
                        acc[ai][bj][m][e >> 1][2 * (e & 1)] *= r0; acc[ai][bj][m][e >> 1][2 * (e & 1) + 1] *= r1; }
                asm volatile("" ::: "memory"); }
    }
    __device__ __forceinline__ void operator()(const f32x4 (&acc)[2][2][4][2], const Unit& u, int wr, int wc, int fr, int fq) const {
        const int row0 = u.pm * BM + wr * 64 + fr, col0 = u.pn * BM + wc * 32 + 8 * fq;
#pragma unroll
        for (int ai = 0; ai < 2; ++ai)
#pragma unroll
            for (int m = 0; m < 4; ++m) { const size_t row = (size_t)(row0 + ai * HALF + m * 16);
#pragma unroll
                for (int bj = 0; bj < 2; ++bj) { const u32x4 g = *(const u32x4*)(G + row * ldg + 2 * 2048 + col0 + bj * HALF);
                    const f32x4 v0 = acc[ai][bj][m][0], v1 = acc[ai][bj][m][1];
                    u32x4 w; w.x = cvt_pk_bf16(v0[0] * bf_lo(g.x), v0[1] * bf_hi(g.x)); w.y = cvt_pk_bf16(v0[2] * bf_lo(g.y), v0[3] * bf_hi(g.y));
                    w.z = cvt_pk_bf16(v1[0] * bf_lo(g.z), v1[1] * bf_hi(g.z)); w.w = cvt_pk_bf16(v1[2] * bf_lo(g.w), v1[3] * bf_hi(g.w));
                    *(u32x4*)(O + row * ldo + col0 + bj * HALF) = w; } }
    }
};

struct EpiResid {
    static constexpr bool PERM = false, MIDK = false;
    float* C; int ldc; float alpha;
    __device__ __forceinline__ void operator()(const f32x4 (&acc)[2][2][4][2], const Unit& u, int wr, int wc, int fr, int fq) const {
        const int row0 = u.pm * BM + wr * 64 + fr, col0 = u.pn * BM + wc * 32 + 4 * fq;
#pragma unroll
        for (int ai = 0; ai < 2; ++ai)
#pragma unroll
            for (int m = 0; m < 4; ++m) { float* rowp = C + (size_t)(row0 + ai * HALF + m * 16) * ldc + col0;
#pragma unroll
                for (int bj = 0; bj < 2; ++bj)
#pragma unroll
                    for (int n = 0; n < 2; ++n) { f32x4* p = (f32x4*)(rowp + bj * HALF + n * 16); *p = *p * alpha + acc[ai][bj][m][n]; } }
    }
};

struct SinglePtrs { const bf16_t* A; const bf16_t* Bt;
    __device__ __forceinline__ void bases(const Unit& u, size_t tA, size_t tB, const char*& a, const char*& b) const { a = (const char*)A + (size_t)u.pm * tA; b = (const char*)Bt + (size_t)u.pn * tB; } };
struct MultiPtrs { const bf16_t *A0, *B0, *A1, *B1, *A2, *B2, *A3, *B3, *A4, *B4;
    __device__ __forceinline__ void bases(const Unit& u, size_t tA, size_t tB, const char*& a, const char*& b) const {
        const int j = u.job;
        const bf16_t* pa = j == 1 ? A1 : j == 2 ? A2 : j == 3 ? A3 : j == 4 ? A4 : A0;
        const bf16_t* pb = j == 1 ? B1 : j == 2 ? B2 : j == 3 ? B3 : j == 4 ? B4 : B0;
        a = (const char*)pa + (size_t)u.pm * tA; b = (const char*)pb + (size_t)u.pn * tB; } };

template <class Epi, class Sched, class Ptrs, bool ALIGN_EPI = true>
__device__ __forceinline__ void gemm_phase(PG8_LAS unsigned char* lds, const Gemm g, const Sched& S, const Ptrs& P, const Epi& E) {
    const int tid = threadIdx.x, wid = __builtin_amdgcn_readfirstlane(tid >> 6), lane = tid & 63, wr = wid >> 2, wc = wid & 3, fr = lane & 15, fq = lane >> 4;
    const int K = g.K, nt = K / BK;
    unsigned voffA[2], voffB[2];
#pragma unroll
    for (int i = 0; i < 2; ++i) { int R, C; stage_rc(tid * 16 + i * 8192, R, C); const int Rb = Epi::PERM ? ((R & ~31) + perm32(R & 31)) : R;
        voffA[i] = (unsigned)(R * g.lda + C) * 2u; voffB[i] = (unsigned)(Rb * g.ldb + C) * 2u; }
    const size_t kstep = (size_t)(BK * 2);
    const size_t hA = (size_t)HALF * g.lda * 2, hB = (size_t)HALF * g.ldb * 2;
    const size_t tA = 2 * hA, tB = 2 * hB;
    const unsigned ldsw = (unsigned)wid * 1024u;
    const int aoff = lds_byte(wr * 64 + fr, fq * 8), boff = lds_byte(wc * 32 + fr, fq * 8);
#define PG8_SA(b, h) (((b) * 2 + (h)) * HTB)
#define PG8_SB(b, h) ((4 + (b) * 2 + (h)) * HTB)
#define PG8_STAGE(bufoff, gbase, voff) do { _Pragma("unroll") for (int _i = 0; _i < 2; ++_i) \
        __builtin_amdgcn_global_load_lds((const unsigned*)((const char*)(gbase) + (voff)[_i]), (PG8_LAS unsigned*)(lds + (bufoff) + ldsw + _i * 8192), 16, 0, 0); } while (0)
#define PG8_LDA(dst, b, h) do { _Pragma("unroll") for (int m = 0; m < 4; ++m) _Pragma("unroll") for (int k = 0; k < 2; ++k) dst[m][k] = *(const PG8_LAS bf16x8*)(lds + PG8_SA(b, h) + aoff + m * 2048 + k * 1024); } while (0)
#define PG8_LDB(dst, b, h) do { _Pragma("unroll") for (int n = 0; n < 2; ++n) _Pragma("unroll") for (int k = 0; k < 2; ++k) dst[n][k] = *(const PG8_LAS bf16x8*)(lds + PG8_SB(b, h) + boff + n * 2048 + k * 1024); } while (0)
#define PG8_MMA(ai, bj, At, Bt) do { __builtin_amdgcn_s_setprio(1); _Pragma("unroll") for (int m = 0; m < 4; ++m) _Pragma("unroll") for (int n = 0; n < 2; ++n) _Pragma("unroll") for (int k = 0; k < 2; ++k) \
        acc[ai][bj][m][n] = __builtin_amdgcn_mfma_f32_16x16x32_bf16(Bt[n][k], At[m][k], acc[ai][bj][m][n], 0, 0, 0); __builtin_amdgcn_s_setprio(0); } while (0)
#define PG8_WAIT_V(n) asm volatile("s_waitcnt vmcnt(" #n ")" ::: "memory")
#define PG8_WAIT_L(n) asm volatile("s_waitcnt lgkmcnt(" #n ")" ::: "memory")
#define PG8_BAR __builtin_amdgcn_s_barrier()
#define PG8_SCHED __builtin_amdgcn_sched_barrier(0)
    Unit cur, nxt; int ui = 0;
    if (!S.next(0, cur)) return;
    f32x4 acc[2][2][4][2];
#pragma unroll
    for (int a = 0; a < 2; ++a)
#pragma unroll
        for (int b = 0; b < 2; ++b)
#pragma unroll
            for (int m = 0; m < 4; ++m)
#pragma unroll
                for (int n = 0; n < 2; ++n) acc[a][b][m][n] = (f32x4){0.f, 0.f, 0.f, 0.f};
    bf16x8 At[4][2], B0[2][2], B1[2][2];
    const char* cA; const char* cB; P.bases(cur, tA, tB, cA, cB);
    PG8_STAGE(PG8_SB(0, 0), cB, voffB); PG8_STAGE(PG8_SB(0, 1), cB + hB, voffB); PG8_STAGE(PG8_SA(0, 0), cA, voffA); PG8_STAGE(PG8_SA(0, 1), cA + hA, voffA);
    if (wr == 1) PG8_BAR;
    PG8_WAIT_V(2); PG8_BAR;
    PG8_STAGE(PG8_SB(1, 0), cB + kstep, voffB); PG8_STAGE(PG8_SA(1, 0), cA + kstep, voffA); PG8_STAGE(PG8_SB(1, 1), cB + hB + kstep, voffB);
    PG8_WAIT_V(6); PG8_BAR;
    for (;;) {
        const bool has_next = S.next(ui + 1, nxt);
        const char* nA = cA; const char* nB = cB; if (has_next) P.bases(nxt, tA, tB, nA, nB);
        for (int t = 0; t < nt; t += 2) {
            const bool last = (t == nt - 2);
            const char* a1 = cA + (size_t)(t + 1) * kstep;
            const char* a2 = last ? nA : cA + (size_t)(t + 2) * kstep; const char* b2 = last ? nB : cB + (size_t)(t + 2) * kstep;
            const char* a3 = a2 + kstep; const char* b3 = b2 + kstep;
            if constexpr (Epi::MIDK) { if (t == 16 || t == 32) E.mid(acc, cur, t >> 4, wr, wc, fr, fq); }
            PG8_LDB(B0, 0, 0); PG8_LDB(B1, 0, 1); PG8_SCHED; PG8_LDA(At, 0, 0); PG8_STAGE(PG8_SA(1, 1), a1 + hA, voffA);
            PG8_WAIT_V(8); PG8_WAIT_L(0); PG8_BAR; PG8_MMA(0, 0, At, B0); PG8_MMA(0, 1, At, B1); PG8_BAR; PG8_SCHED;
            PG8_LDA(At, 0, 1); PG8_STAGE(PG8_SB(0, 0), b2, voffB); PG8_STAGE(PG8_SB(0, 1), b2 + hB, voffB); PG8_STAGE(PG8_SA(0, 0), a2, voffA);
            PG8_WAIT_V(8); PG8_WAIT_L(0); PG8_BAR; PG8_MMA(1, 0, At, B0); PG8_MMA(1, 1, At, B1); PG8_BAR; PG8_SCHED;
            PG8_LDB(B0, 1, 0); PG8_LDB(B1, 1, 1); PG8_SCHED; PG8_LDA(At, 1, 0); PG8_STAGE(PG8_SA(0, 1), a2 + hA, voffA);
            PG8_WAIT_V(8); PG8_WAIT_L(0); PG8_BAR; PG8_MMA(0, 0, At, B0); PG8_MMA(0, 1, At, B1); PG8_BAR; PG8_SCHED;
            PG8_LDA(At, 1, 1); PG8_STAGE(PG8_SB(1, 0), b3, voffB); PG8_STAGE(PG8_SB(1, 1), b3 + hB, voffB); PG8_STAGE(PG8_SA(1, 0), a3, voffA);
            PG8_WAIT_V(8); PG8_WAIT_L(0); PG8_BAR; PG8_MMA(1, 0, At, B0); PG8_MMA(1, 1, At, B1); PG8_BAR; PG8_SCHED;
        }
        if constexpr (ALIGN_EPI) { if (wr == 0) PG8_BAR; }
        E(acc, cur, wr, wc, fr, fq);
        if (!has_next) break;
#pragma unroll
        for (int a = 0; a < 2; ++a)
#pragma unroll
            for (int b = 0; b < 2; ++b)
#pragma unroll
                for (int m = 0; m < 4; ++m)
#pragma unroll
                    for (int n = 0; n < 2; ++n) acc[a][b][m][n] = (f32x4){0.f, 0.f, 0.f, 0.f};
        cur = nxt; cA = nA; cB = nB; ++ui;
        if constexpr (ALIGN_EPI) { if (wr == 1) PG8_BAR; }
    }
    PG8_WAIT_V(0);
    if constexpr (!ALIGN_EPI) { if (wr == 0) PG8_BAR; }
    PG8_BAR;
#undef PG8_SA
#undef PG8_SB
#undef PG8_STAGE
#undef PG8_LDA
#undef PG8_LDB
#undef PG8_MMA
#undef PG8_WAIT_V
#undef PG8_WAIT_L
#undef PG8_BAR
#undef PG8_SCHED
}
}
namespace att {
#define ATT_LAS __attribute__((address_space(3)))
typedef unsigned short bf16_t;
typedef short bf16x8 __attribute__((ext_vector_type(8)));
typedef float f32x16 __attribute__((ext_vector_type(16)));
typedef unsigned u32x4 __attribute__((ext_vector_type(4)));
typedef unsigned u32x2 __attribute__((ext_vector_type(2)));
constexpr float LOG2E = 1.4426950408889634f;
constexpr float NEGBIG = -1e30f;
constexpr int VROW = 136;
constexpr int BIAS_OFF = 120 * 1024;
constexpr int BIAS_STRIDE = 1040;
constexpr int SCR_OFF = 123 * 1024;
constexpr int XCH_OFF = 0;

__device__ __forceinline__ unsigned pk_bf16(float lo, float hi) { unsigned r; asm volatile("v_cvt_pk_bf16_f32 %0, %1, %2" : "=v"(r) : "v"(lo), "v"(hi)); return r; }

__device__ __forceinline__ int t5_bucket(int rel) {
    const int n = rel < 0 ? -rel : rel; const int ret = rel > 0 ? 16 : 0;
    const float nf = (float)(n < 1 ? 1 : n);
    int large = 8 + (int)(logf(nf / 8.0f) / 2.7725887222397811f * 8.0f);
    large = large < 15 ? large : 15;
    return ret + (n < 8 ? n : large);
}
__device__ __forceinline__ void fill_bias(ATT_LAS unsigned char* lds, int t, const float* rel_table, int col) {
    ATT_LAS float* tab = (ATT_LAS float*)(lds + BIAS_OFF + t * BIAS_STRIDE);
    for (int i = threadIdx.x; i < 257; i += 512) tab[i] = rel_table[t5_bucket(i - 128) * 16 + col] * LOG2E;
}

struct Desc {
    const bf16_t* Qw; int ldq;
    const bf16_t* K;  int ldk;
    const bf16_t* Vt; int ldv;
    bf16_t* Ow; int ldo;
    int qpos0;
    int kt0, kt1;
    int btab;
    int kcol0;
    float sink2;
    float lam;
    const float* subg;
};

template <int KW, int DQK, bool BIAS, bool WIN, bool DIFF, int THR>
__device__ __forceinline__ void attn_unit(ATT_LAS unsigned char* lds, const Desc& D) {
    constexpr int KROW = KW * 2 + 16, CPR = KW / 8, NKC = 64 * CPR / 512, NDC = DQK / 16;
    constexpr int KBYTES = 64 * KROW, BUFB = KBYTES + 128 * VROW;
    static_assert(2 * BUFB <= BIAS_OFF, "attention LDS map");
    int tid_ = threadIdx.x; asm volatile("" : "+v"(tid_));
    const int tid = tid_, lane = tid & 63, r = lane & 31, h = lane >> 5, wid = __builtin_amdgcn_readfirstlane(tid >> 6);
    constexpr bool QHOLD = (DQK <= 128);
    constexpr int NQF = QHOLD ? NDC : 8;
    bf16x8 qf[NQF];
    const char* qb_ = (const char*)D.Qw; const unsigned qo = (unsigned)(r * D.ldq + 8 * h) * 2u;
    if (QHOLD) {
#pragma unroll
      for (int dc = 0; dc < NQF; ++dc) qf[dc] = *(const bf16x8*)(qb_ + qo + 32 * dc); }
    const ATT_LAS float* tab = (const ATT_LAS float*)(lds + BIAS_OFF + D.btab * BIAS_STRIDE);
    ATT_LAS float* scr = (ATT_LAS float*)(lds + SCR_OFF) + wid * 32;
    const int qpos = D.qpos0 + r;
    float bfarL = 0.f, bfarR = 0.f; if (BIAS) { bfarL = tab[0]; bfarR = tab[256]; }
    u32x4 kreg[NKC], vreg[2];
    const char* Kb = (const char*)D.K; const char* Vb = (const char*)D.Vt;
    unsigned koff[NKC], voff[2], klds[NKC], vlds[2];
#pragma unroll
    for (int i = 0; i < NKC; ++i) { const int c = tid + 512 * i, row = c / CPR, cc = c % CPR; koff[i] = (unsigned)(row * D.ldk + cc * 8) * 2u; klds[i] = (unsigned)(row * KROW + cc * 16); }
#pragma unroll
    for (int i = 0; i < 2; ++i) { const int c = tid + 512 * i, row = c >> 3, cc = c & 7; voff[i] = (unsigned)(row * D.ldv + cc * 8) * 2u; vlds[i] = (unsigned)(KBYTES + row * VROW + cc * 16); }
#define ATT_LOAD(kt) do { const char* kb_ = Kb + (size_t)(kt) * 128 * D.ldk; const char* vb_ = Vb + (size_t)(kt) * 128; \
        _Pragma("unroll") for (int i = 0; i < NKC; ++i) kreg[i] = *(const u32x4*)(kb_ + koff[i]); \
        _Pragma("unroll") for (int i = 0; i < 2; ++i) vreg[i] = *(const u32x4*)(vb_ + voff[i]); } while (0)
#define ATT_STORE(boff) do { _Pragma("unroll") for (int i = 0; i < NKC; ++i) *(ATT_LAS u32x4*)(lds + (boff) + klds[i]) = kreg[i]; \
        _Pragma("unroll") for (int i = 0; i < 2; ++i) { ATT_LAS u32x2* p_ = (ATT_LAS u32x2*)(lds + (boff) + vlds[i]); p_[0] = (u32x2){vreg[i].x, vreg[i].y}; p_[1] = (u32x2){vreg[i].z, vreg[i].w}; } } while (0)

    float m = WIN ? D.sink2 : NEGBIG, l = (WIN && h == 0) ? 1.f : 0.f;
    f32x16 o[4];
#pragma unroll
    for (int db = 0; db < 4; ++db) o[db] = (f32x16){};
    ATT_LOAD(D.kt0); ATT_STORE(0); __syncthreads();
    int cur = 0;
    for (int kt = D.kt0; kt < D.kt1; ++kt) {
        if (kt + 1 < D.kt1) ATT_LOAD(kt + 1);
        const int boff = cur * BUFB;
        const int relmin = kt * 64 - (D.qpos0 + 31), relmax = kt * 64 + 63 - D.qpos0;
        const bool active = !WIN || (relmax >= -128 && relmin <= 128);
        if (active) {
            const bool farR = BIAS && relmin >= 91, farL = BIAS && relmax <= -91, need_mask = WIN && (relmin < -128 || relmax > 128);
            const float cinit = farR ? bfarR : (farL ? bfarL : 0.f);
            f32x16 s[2];
#pragma unroll
            for (int hh = 0; hh < 2; ++hh)
#pragma unroll
                for (int i = 0; i < 16; ++i) s[hh][i] = cinit;
#pragma unroll
            for (int qh_ = 0; qh_ < NDC / NQF; ++qh_) {
                if (!QHOLD) {
#pragma unroll
                    for (int dc = 0; dc < NQF; ++dc) qf[dc] = *(const bf16x8*)(qb_ + qo + 32 * (qh_ * NQF + dc)); }
#pragma unroll
                for (int hh = 0; hh < 2; ++hh)
#pragma unroll
                    for (int dc = 0; dc < NQF; ++dc) { const bf16x8 kf = *(const ATT_LAS bf16x8*)(lds + boff + (32 * hh + r) * KROW + (D.kcol0 + 16 * (qh_ * NQF + dc) + 8 * h) * 2);
                        s[hh] = __builtin_amdgcn_mfma_f32_32x32x16_bf16(kf, qf[dc], s[hh], 0, 0, 0); }
            }
            if (BIAS && !farR && !farL) {
#pragma unroll
                for (int hh = 0; hh < 2; ++hh)
#pragma unroll
                    for (int i = 0; i < 16; ++i) { const int rel = kt * 64 + 32 * hh + (i & 3) + 8 * (i >> 2) + 4 * h - qpos; const int ix = rel < -128 ? -128 : (rel > 128 ? 128 : rel); s[hh][i] += tab[ix + 128]; }
            }
            if (need_mask) {
#pragma unroll
                for (int hh = 0; hh < 2; ++hh)
#pragma unroll
                    for (int i = 0; i < 16; ++i) { const int rel = kt * 64 + 32 * hh + (i & 3) + 8 * (i >> 2) + 4 * h - qpos; if (rel < -128 || rel > 128) s[hh][i] = NEGBIG; }
            }
            float tm = fmaxf(s[0][0], s[1][0]);
#pragma unroll
            for (int i = 1; i < 16; ++i) tm = fmaxf(tm, fmaxf(s[0][i], s[1][i]));
            tm = fmaxf(tm, __shfl_xor(tm, 32));
            if (__any(tm > m + (float)THR)) {
                const float mn = fmaxf(m, tm), f = __builtin_amdgcn_exp2f(m - mn);
                m = mn; l *= f;
                if (h == 0) scr[r] = f;
                asm volatile("s_waitcnt lgkmcnt(0)" ::: "memory");
#pragma unroll
                for (int i = 0; i < 16; ++i) { const float fi = scr[(i & 3) + 8 * (i >> 2) + 4 * h];
#pragma unroll
                    for (int db = 0; db < 4; ++db) o[db][i] *= fi; }
            }
#pragma unroll
            for (int hh = 0; hh < 2; ++hh) {
                float p[16];
#pragma unroll
                for (int i = 0; i < 16; ++i) { p[i] = __builtin_amdgcn_exp2f(s[hh][i] - m); l += p[i]; }
#pragma unroll
                for (int ks = 0; ks < 2; ++ks) {
                    u32x4 pw; pw.x = pk_bf16(p[8 * ks + 0], p[8 * ks + 1]); pw.y = pk_bf16(p[8 * ks + 2], p[8 * ks + 3]); pw.z = pk_bf16(p[8 * ks + 4], p[8 * ks + 5]); pw.w = pk_bf16(p[8 * ks + 6], p[8 * ks + 7]);
                    const bf16x8 pf = __builtin_bit_cast(bf16x8, pw);
#pragma unroll
                    for (int db = 0; db < 4; ++db) {
                        const ATT_LAS u32x2* vp = (const ATT_LAS u32x2*)(lds + boff + KBYTES + (32 * db + r) * VROW + (32 * hh + 16 * ks + 4 * h) * 2);
                        const u32x2 v0 = vp[0], v1 = vp[2];
                        const bf16x8 vf = __builtin_bit_cast(bf16x8, (u32x4){v0.x, v0.y, v1.x, v1.y});
                        o[db] = __builtin_amdgcn_mfma_f32_32x32x16_bf16(pf, vf, o[db], 0, 0, 0);
                    }
                }
            }
        }
        if (kt + 1 < D.kt1) ATT_STORE((cur ^ 1) * BUFB);
        __syncthreads();
        cur ^= 1;
    }
    {
        const float lt = l + __shfl_xor(l, 32);
        if (h == 0) scr[r] = 1.0f / lt;
        asm volatile("s_waitcnt lgkmcnt(0)" ::: "memory");
#pragma unroll
        for (int i = 0; i < 16; ++i) { const float fi = scr[(i & 3) + 8 * (i >> 2) + 4 * h];
#pragma unroll
            for (int db = 0; db < 4; ++db) o[db][i] *= fi; }
    }
    if (DIFF) {
        ATT_LAS float* xch = (ATT_LAS float*)(lds + XCH_OFF) + (wid & 3) * 4096 + lane;
        if (wid >= 4) {
#pragma unroll
            for (int db = 0; db < 4; ++db)
#pragma unroll
                for (int i = 0; i < 16; ++i) xch[(db * 16 + i) * 64] = o[db][i];
        }
        __syncthreads();
        if (wid < 4) {
#pragma unroll
            for (int db = 0; db < 4; ++db)
#pragma unroll
                for (int i = 0; i < 16; ++i) o[db][i] -= D.lam * xch[(db * 16 + i) * 64];
            float gain[4];
#pragma unroll
            for (int db = 0; db < 4; ++db) gain[db] = D.subg[32 * db + r] * 0.8f;
#pragma unroll
            for (int i = 0; i < 16; ++i) {
                float ss = 0.f;
#pragma unroll
                for (int db = 0; db < 4; ++db) ss += o[db][i] * o[db][i];
                ss += __shfl_xor(ss, 1); ss += __shfl_xor(ss, 2); ss += __shfl_xor(ss, 4); ss += __shfl_xor(ss, 8); ss += __shfl_xor(ss, 16);
                const float rs = 1.0f / sqrtf(ss * (1.0f / 128.0f) + 1e-5f);
#pragma unroll
                for (int db = 0; db < 4; ++db) o[db][i] = o[db][i] * rs * gain[db];
            }
        }
    }
    if (!DIFF || wid < 4) {
#pragma unroll
        for (int i = 0; i < 16; ++i) { const int q = (i & 3) + 8 * (i >> 2) + 4 * h; char* ob_ = (char*)D.Ow; const unsigned oo = (unsigned)(q * D.ldo + r) * 2u;
#pragma unroll
            for (int db = 0; db < 4; ++db) *(bf16_t*)(ob_ + oo + 64 * db) = (bf16_t)(pk_bf16(o[db][i], 0.f) & 0xffffu); }
    }
    if (DIFF) __syncthreads();
#undef ATT_LOAD
#undef ATT_STORE
}
}
constexpr int NWAVES = 8;
#ifndef MK_N_LAUNCHES
#define MK_N_LAUNCHES 1
#endif
constexpr int N_PHASES = 10;
constexpr int N_LAUNCHES = MK_N_LAUNCHES;

constexpr int BATCH = 4, SEQ = 2048, D = 2048, T = BATCH * SEQ, NMEM = 256, TM = BATCH * NMEM;
constexpr int IN_W = 5632, NQK = 4352, NV = 1280, NG = 6144, DFF = 5504, NUP = 2 * DFF, NBR = 3072;
constexpr float LN_EPS = 1e-5f;
constexpr float ALPHA = 1.189207115002721f;
constexpr int C_DQ = 0, C_DK = 1024, C_WQ = 2048, C_WK = 3072, C_MQ = 3328;

constexpr size_t MiB = 1u << 20;
constexpr size_t WS_CTL = 0, CTL_ZERO_BYTES = 64 * 1024;
constexpr size_t WS_WBR = 1 * MiB;
constexpr size_t WS_WO = 13 * MiB;
constexpr size_t WS_WINQK = 21 * MiB;
constexpr size_t WS_WINV = 38 * MiB;
constexpr size_t WS_WGATE = 43 * MiB;
constexpr size_t WS_WMEM = 67 * MiB;
constexpr size_t WS_H0B = 75 * MiB;
constexpr size_t WS_MEMB = 107 * MiB;
constexpr size_t WS_QKP = 111 * MiB;
constexpr size_t WS_VT = 179 * MiB;
constexpr size_t WS_MK = 199 * MiB;
constexpr size_t WS_MVT = 201 * MiB;
constexpr size_t WS_GATES = 203 * MiB;
constexpr size_t WS_BR = 299 * MiB;
constexpr size_t WS_MIXED = 21 * MiB;
constexpr size_t WS_H1B = 53 * MiB;
constexpr size_t WS_WUP = 111 * MiB;
constexpr size_t WS_WDOWN = 154 * MiB;
constexpr size_t WS_U = 176 * MiB;
constexpr size_t WS_ACT = 21 * MiB;
constexpr size_t WS_END = 348 * MiB;
constexpr int CW_BAR = 1024;

constexpr int RING_BYTES = 131072, LDSCTL_OFF = RING_BYTES, MISC_OFF = LDSCTL_OFF + 320, LDS_BYTES = 147456;

#define GAS __attribute__((address_space(1)))
#define LAS __attribute__((address_space(3)))
typedef unsigned short bf16;
typedef unsigned v4u __attribute__((ext_vector_type(4)));
typedef unsigned v2u __attribute__((ext_vector_type(2)));
typedef float f32x4 __attribute__((ext_vector_type(4)));
#define LDS_WAIT() asm volatile("s_waitcnt lgkmcnt(0)" ::: "memory")
__device__ __forceinline__ unsigned f2bf(float f) { unsigned u = __builtin_bit_cast(unsigned, f); return (u + 0x7fffu + ((u >> 16) & 1u)) >> 16; }
__device__ __forceinline__ unsigned pk2(float lo, float hi) { return f2bf(lo) | (f2bf(hi) << 16); }
__device__ __forceinline__ float bflo(unsigned w) { return __uint_as_float(w << 16); }
__device__ __forceinline__ float bfhi(unsigned w) { return __uint_as_float(w & 0xffff0000u); }

#define XB_TMO      128
#define XB_XCNT(j)  (256  + 64 * (j))
#define XB_XSUB(j)  (1280 + 64 * (j))
#define XB_XGEN(j)  (2304 + 64 * (j))
#define XB_TOP      3328
#define XB_TOPGEN   3392
#define XCD_BAR_WORDS 3456
#define XB_SPIN_CAP (1u << 20)
__device__ __forceinline__ unsigned xb_ld(unsigned* p)              { return __hip_atomic_load(p, __ATOMIC_RELAXED, __HIP_MEMORY_SCOPE_AGENT); }
__device__ __forceinline__ unsigned xb_add(unsigned* p, unsigned v) { return __hip_atomic_fetch_add(p, v, __ATOMIC_RELAXED, __HIP_MEMORY_SCOPE_AGENT); }
__device__ __forceinline__ unsigned xb_xcc_id() { return (unsigned)__builtin_amdgcn_s_getreg((3 << 11) | 20) & 0xFu; }
#define XB_SPIN(cond, bar) do { unsigned _sp = 0; while (cond) { __builtin_amdgcn_s_sleep(1); \
    if ((++_sp & 255u) == 0u) { if (xb_ld(&(bar)[XB_TMO])) break; if (_sp > XB_SPIN_CAP) { atomicAdd(&(bar)[XB_TMO], 1u); break; } } } } while (0)
struct XcdBarrier { unsigned* bar; unsigned x; volatile LAS unsigned* st; };
__device__ __forceinline__ XcdBarrier xcd_barrier_post(unsigned* bar, volatile LAS unsigned* st) {
    XcdBarrier b; b.bar = bar; b.x = xb_xcc_id(); b.st = st;
    if (threadIdx.x == 0) (void)xb_add(&bar[XB_XCNT(b.x)], 1u);
    return b;
}
__device__ __forceinline__ void xcd_barrier_complete(unsigned* bar, unsigned x, unsigned& nloc, unsigned& nx) {
    const unsigned G = gridDim.x * gridDim.y * gridDim.z;
    unsigned sum, cnt, mine, sp = 0u;
    for (;;) {
        sum = 0u; cnt = 0u; mine = 0u;
#pragma unroll
        for (unsigned j = 0; j < 16; ++j) { const unsigned c = xb_ld(&bar[XB_XCNT(j)]); sum += c; cnt += (c > 0u) ? 1u : 0u; mine = (j == x) ? c : mine; }
        if (sum == G) break;
        __builtin_amdgcn_s_sleep(1);
        if ((++sp & 255u) == 0u) { if (xb_ld(&bar[XB_TMO])) break; if (sp > XB_SPIN_CAP) { atomicAdd(&bar[XB_TMO], 1u); break; } }
    }
    nloc = mine > 0u ? mine : 1u; nx = cnt > 0u ? cnt : 1u;
}
__device__ __forceinline__ void xcd_barrier(const XcdBarrier& b) {
    asm volatile("s_waitcnt vmcnt(0)" ::: "memory");
    __syncthreads();
    if (threadIdx.x == 0) {
        unsigned* bar = b.bar;
        __builtin_amdgcn_s_waitcnt(0);
        unsigned nloc = b.st[0], nx = b.st[1];
        if (nloc == 0u) { xcd_barrier_complete(bar, b.x, nloc, nx); b.st[0] = nloc; b.st[1] = nx; }
        const unsigned old = xb_add(&bar[XB_XSUB(b.x)], 1u);
        const unsigned gen = old / nloc;
        if (old + 1u == (gen + 1u) * nloc) {
            __builtin_amdgcn_fence(__ATOMIC_RELEASE, "agent");
            asm volatile("s_waitcnt vmcnt(0)" ::: "memory");
            const unsigned og = xb_add(&bar[XB_TOP], 1u);
            const unsigned tg = og / nx;
            if (og + 1u == (tg + 1u) * nx) xb_add(&bar[XB_TOPGEN], 1u);
            else XB_SPIN(xb_ld(&bar[XB_TOPGEN]) == tg, bar);
            __builtin_amdgcn_fence(__ATOMIC_ACQUIRE, "agent");
            xb_add(&bar[XB_XGEN(b.x)], 1u);
            asm volatile("s_waitcnt vmcnt(0)" ::: "memory");
        } else {
            XB_SPIN(xb_ld(&bar[XB_XGEN(b.x)]) == gen, bar);
            __builtin_amdgcn_fence(__ATOMIC_ACQUIRE, "agent");
            asm volatile("s_waitcnt vmcnt(0)" ::: "memory");
        }
    }
    __syncthreads();
}

__device__ __forceinline__ float wave_sum(float v) {
#pragma unroll
    for (int o = 1; o < 64; o <<= 1) v += __shfl_xor(v, o);
    return v;
}
__device__ __forceinline__ void transpose_item(const float* W, int ldw, int K, int ncols, bf16* WT, int ldt, int item, int lane) {
    const int nblk = ncols / 64, kb = item / nblk, nb = item % nblk, k0 = 64 * kb + 16 * (lane >> 4), n0 = 64 * nb + 4 * (lane & 15);
    const GAS float* src = (const GAS float*)W + (size_t)k0 * ldw + n0;
    f32x4 v[16];
#pragma unroll
    for (int i = 0; i < 16; ++i) v[i] = *(const GAS f32x4*)(src + (size_t)i * ldw);
#pragma unroll
    for (int j = 0; j < 4; ++j) {
        GAS v4u* dst = (GAS v4u*)(WT + (size_t)(n0 + j) * ldt + k0);
        v4u o0, o1;
        o0.x = pk2(v[0][j], v[1][j]); o0.y = pk2(v[2][j], v[3][j]); o0.z = pk2(v[4][j], v[5][j]); o0.w = pk2(v[6][j], v[7][j]);
        o1.x = pk2(v[8][j], v[9][j]); o1.y = pk2(v[10][j], v[11][j]); o1.z = pk2(v[12][j], v[13][j]); o1.w = pk2(v[14][j], v[15][j]);
        dst[0] = o0; dst[1] = o1;
    }
}
__device__ __forceinline__ void ln_row(const float* xrow, const float* g, const float* b, float* orow, bf16* brow, int lane) {
    const GAS f32x4* xr = (const GAS f32x4*)xrow + lane;
    f32x4 v[8]; float s = 0.f;
#pragma unroll
    for (int j = 0; j < 8; ++j) { v[j] = xr[64 * j]; s += (v[j].x + v[j].y) + (v[j].z + v[j].w); }
    const float mean = wave_sum(s) * (1.f / D); float s2 = 0.f;
#pragma unroll
    for (int j = 0; j < 8; ++j) { v[j] = v[j] - mean; s2 += (v[j].x * v[j].x + v[j].y * v[j].y) + (v[j].z * v[j].z + v[j].w * v[j].w); }
    const float rstd = 1.f / sqrtf(wave_sum(s2) * (1.f / D) + LN_EPS);
#pragma unroll
    for (int j = 0; j < 8; ++j) {
        const f32x4 gg = ((const GAS f32x4*)g)[lane + 64 * j], bb = ((const GAS f32x4*)b)[lane + 64 * j];
        const f32x4 y = v[j] * rstd * gg + bb;
        if (orow) ((GAS f32x4*)orow)[lane + 64 * j] = y;
        if (brow) ((GAS v2u*)brow)[lane + 64 * j] = (v2u){pk2(y.x, y.y), pk2(y.z, y.w)};
    }
}
__device__ __forceinline__ float gelu_tanh(float x) {
    const float z = 1.5957691216057308f * (x + 0.044715f * x * x * x);
    return x * __builtin_amdgcn_rcpf(1.0f + __builtin_amdgcn_exp2f(-1.4426950408889634f * z));
}
struct Args { const float* in[25]; float* out; unsigned char* ws; int ph_lo, ph_hi; };
enum { I_X = 0, I_MEM, I_LNG, I_LNB, I_REL, I_WIN, I_WMEM, I_LQ1, I_LK1, I_LQ2, I_LK2, I_SUBG, I_SINK, I_WGATE, I_BGATE, I_WBR, I_WO, I_LN1G, I_LN1B, I_WUP, I_CONVW, I_CONVB, I_WDOWN, I_LN2G, I_LN2B };

#ifndef ATT_THR
#define ATT_THR 8
#endif
__device__ __forceinline__ void phase_attention(LAS unsigned char* lds, const Args& args, const bf16* QKP, const bf16* VT, const bf16* MK, const bf16* MVT, bf16* BR, int vcu, int G, int wave, int lane) {
        const float* rel_table = args.in[I_REL];
        float lam;
        { const float s1 = wave_sum(args.in[I_LQ1][lane] * args.in[I_LK1][lane]), s2 = wave_sum(args.in[I_LQ2][lane] * args.in[I_LK2][lane]); lam = expf(s1) - expf(s2) + 0.2f; }
        for (int u = 2 * vcu; u < 512; u += 2 * G)
#pragma unroll 1
          for (int j = 0; j < 2; ++j) {
            const int uu = u + j, b = uu >> 7, h = (uu >> 4) & 7, qb = uu & 15, map = wave >> 2;
            att::fill_bias(lds, 0, rel_table, h); __syncthreads();
            att::Desc d; const size_t row0 = (size_t)b * SEQ + qb * 128 + (wave & 3) * 32;
            d.Qw = QKP + row0 * NQK + C_DQ + h * 128 + map * 64; d.ldq = NQK; d.K = QKP + (size_t)b * SEQ * NQK + C_DK + h * 128; d.ldk = NQK;
            d.Vt = VT + (size_t)(h * 128) * T + (size_t)b * SEQ; d.ldv = T; d.Ow = BR + row0 * NBR + h * 128; d.ldo = NBR;
            d.qpos0 = qb * 128 + (wave & 3) * 32; d.kt0 = 0; d.kt1 = SEQ / 64; d.btab = 0; d.kcol0 = map * 64; d.sink2 = 0.f; d.lam = lam; d.subg = args.in[I_SUBG];
#ifndef SKIP_A
            att::attn_unit<128, 64, true, false, true, ATT_THR>(lds, d);
#endif
        }
        for (int u = vcu; u < 256; u += G) {
            const int b = u >> 6, kvh = (u >> 5) & 1, qb = (u >> 1) & 15, pair = u & 1; const int qh = kvh * 4 + pair * 2 + (wave >> 2), qsub = wave & 3;
            att::fill_bias(lds, 0, rel_table, 8 + kvh * 4 + pair * 2); att::fill_bias(lds, 1, rel_table, 8 + kvh * 4 + pair * 2 + 1); __syncthreads();
            att::Desc d; const size_t row0 = (size_t)b * SEQ + qb * 128 + qsub * 32;
            d.Qw = QKP + row0 * NQK + C_WQ + qh * 128; d.ldq = NQK; d.K = QKP + (size_t)b * SEQ * NQK + C_WK + kvh * 128; d.ldk = NQK;
            d.Vt = VT + (size_t)(1024 + kvh * 128) * T + (size_t)b * SEQ; d.ldv = T; d.Ow = BR + row0 * NBR + 1024 + qh * 128; d.ldo = NBR;
            d.qpos0 = qb * 128 + qsub * 32; d.kt0 = (2 * qb - 2) < 0 ? 0 : (2 * qb - 2); d.kt1 = (2 * qb + 4) > SEQ / 64 ? SEQ / 64 : (2 * qb + 4);
            d.btab = wave >> 2; d.kcol0 = 0; d.sink2 = args.in[I_SINK][qh] * att::LOG2E; d.lam = 0.f; d.subg = nullptr;
#ifndef SKIP_B
            att::attn_unit<128, 128, true, true, false, ATT_THR>(lds, d);
#endif
        }
        for (int u = vcu; u < 256; u += G) {
            const int b = u >> 6, h = (u >> 4) & 3, qb = (u >> 1) & 7, half = u & 1;
            att::Desc d; const size_t row0 = (size_t)b * SEQ + qb * 256 + wave * 32;
            d.Qw = QKP + row0 * NQK + C_MQ + h * 256; d.ldq = NQK; d.K = MK + (size_t)(b * NMEM) * 1024 + h * 256; d.ldk = 1024;
            d.Vt = MVT + (size_t)(h * 256 + half * 128) * TM + b * NMEM; d.ldv = TM; d.Ow = BR + row0 * NBR + 2048 + h * 256 + half * 128; d.ldo = NBR;
            d.qpos0 = 0; d.kt0 = 0; d.kt1 = NMEM / 64; d.btab = 0; d.kcol0 = 0; d.sink2 = 0.f; d.lam = 0.f; d.subg = nullptr;
#ifndef SKIP_C
            att::attn_unit<256, 256, false, false, false, ATT_THR>(lds, d);
#endif
        }
}

__global__ void __launch_bounds__(NWAVES * 64, 2) mega_fwd(Args args) {
    extern __shared__ __attribute__((aligned(16))) unsigned char lds_raw[];
    LAS unsigned char* lds = (LAS unsigned char*)lds_raw;
    volatile LAS unsigned* MISC = (volatile LAS unsigned*)(lds + MISC_OFF);
    const int tid = threadIdx.x, lane = tid & 63, wave = __builtin_amdgcn_readfirstlane(tid >> 6);
    const int G = gridDim.x, bx = blockIdx.x;
    const int vcu = (G % 8 == 0) ? (bx % 8) * (G / 8) + bx / 8 : bx;
    unsigned char* ws = args.ws;
    for (int u = tid; u < (LDS_BYTES - LDSCTL_OFF) / 4; u += NWAVES * 64) ((LAS unsigned*)(lds + LDSCTL_OFF))[u] = 0u;
    __syncthreads();
    XcdBarrier bar; bar.bar = (unsigned*)(ws + WS_CTL) + CW_BAR; bar.x = 0; bar.st = nullptr;
    if (N_LAUNCHES == 1) bar = xcd_barrier_post((unsigned*)(ws + WS_CTL) + CW_BAR, MISC + 8);
#define GRID_BAR() do { if (N_LAUNCHES == 1) xcd_barrier(bar); } while (0)
#ifdef PROBE_TS
    unsigned long long* const ts_ = (unsigned long long*)(ws + 32768);
#define STAMP(k) do { if (bx == 0 && tid == 0) ts_[k] = __builtin_amdgcn_s_memrealtime(); } while (0)
    STAMP(0);
#else
#define STAMP(k) do {} while (0)
#endif
    const int lo = args.ph_lo, hi = args.ph_hi;
#define IN(k) (lo <= (k) && (k) < hi)
    float* out = args.out;
    bf16* const Wbr_t = (bf16*)(ws + WS_WBR); bf16* const Wo_t = (bf16*)(ws + WS_WO); bf16* const WinQK_t = (bf16*)(ws + WS_WINQK); bf16* const WinV_t = (bf16*)(ws + WS_WINV);
    bf16* const Wgate_t = (bf16*)(ws + WS_WGATE); bf16* const Wmem_t = (bf16*)(ws + WS_WMEM); bf16* const H0b = (bf16*)(ws + WS_H0B); bf16* const MEMb = (bf16*)(ws + WS_MEMB);
    bf16* const QKP = (bf16*)(ws + WS_QKP); bf16* const VT = (bf16*)(ws + WS_VT); bf16* const MK = (bf16*)(ws + WS_MK); bf16* const MVT = (bf16*)(ws + WS_MVT);
    bf16* const GATES = (bf16*)(ws + WS_GATES); bf16* const BR = (bf16*)(ws + WS_BR); bf16* const MIXED = (bf16*)(ws + WS_MIXED);
    bf16* const H1b = (bf16*)(ws + WS_H1B); bf16* const Wup_t = (bf16*)(ws + WS_WUP); bf16* const Wdown_t = (bf16*)(ws + WS_WDOWN); bf16* const U = (bf16*)(ws + WS_U); bf16* const ACT = (bf16*)(ws + WS_ACT);
    const int gw = vcu * NWAVES + wave, NGW = G * NWAVES;
#define TJOBP(src, ldw, K, ncols, dst, ldt) { const int n_ = ((K) / 64) * ((ncols) / 64); if (r < n_) { transpose_item((src), (ldw), (K), (ncols), (dst), (ldt), r, lane); continue; } r -= n_; }
#define TJOB(src, ldw, K, ncols, dst) { const int n_ = ((K) / 64) * ((ncols) / 64); if (r < n_) { transpose_item((src), (ldw), (K), (ncols), (dst), (K), r, lane); continue; } r -= n_; }

    if (IN(0)) {
        const float* w_in = args.in[I_WIN];
        constexpr int I1 = 32 * 16, I2 = 32 * 4;
        constexpr int NIT = 5 * I1 + 2 * I2 + 32 * (NG / 64) + 32 * 32 + 3 * (16 * 32) + 32 * 32;
        for (int it = gw; it < NIT; it += NGW) {
            int r = it;
            TJOB(w_in + 0, IN_W, 2048, 1024, WinQK_t + (size_t)C_DQ * 2048)
            TJOB(w_in + 1024, IN_W, 2048, 1024, WinQK_t + (size_t)C_DK * 2048)
            TJOB(w_in + 2048, IN_W, 2048, 1024, WinV_t)
            TJOB(w_in + 3072, IN_W, 2048, 1024, WinQK_t + (size_t)C_WQ * 2048)
            TJOB(w_in + 4096, IN_W, 2048, 256, WinQK_t + (size_t)C_WK * 2048)
            TJOB(w_in + 4352, IN_W, 2048, 256, WinV_t + (size_t)1024 * 2048)
            TJOB(w_in + 4608, IN_W, 2048, 1024, WinQK_t + (size_t)C_MQ * 2048)
            TJOB(args.in[I_WGATE], NG, 2048, NG, Wgate_t)
            TJOB(args.in[I_WMEM], 2048, 2048, 2048, Wmem_t)
            TJOBP(args.in[I_WBR], 2048, 1024, 2048, Wbr_t, NBR)
            TJOBP(args.in[I_WBR] + (size_t)1024 * 2048, 2048, 1024, 2048, Wbr_t + 1024, NBR)
            TJOBP(args.in[I_WBR] + (size_t)2 * 1024 * 2048, 2048, 1024, 2048, Wbr_t + 2048, NBR)
            TJOB(args.in[I_WO], 2048, 2048, 2048, Wo_t)
        }
        for (int m = gw; m < T; m += NGW) ln_row(args.in[I_X] + (size_t)m * D, args.in[I_LNG], args.in[I_LNB], out + (size_t)m * D, H0b + (size_t)m * D, lane);
        for (int m = gw; m < TM; m += NGW) { const GAS f32x4* xr = (const GAS f32x4*)(args.in[I_MEM] + (size_t)m * D) + lane; GAS v2u* o = (GAS v2u*)(MEMb + (size_t)m * D) + lane;
#pragma unroll
            for (int j = 0; j < 8; ++j) { const f32x4 v = xr[64 * j]; o[64 * j] = (v2u){pk2(v.x, v.y), pk2(v.z, v.w)}; } }
        if (IN(1)) GRID_BAR();
        STAMP(1);
    }

    if (IN(1)) {
        pg8::Gemm g{nullptr, nullptr, 2048, 2048, 0, 0, 2048};
        pg8::MultiOrder S; S.G = G; S.c = bx;
        S.nM0 = T / 256;  S.nN0 = NG / 256;
        S.nM1 = T / 256;  S.nN1 = NQK / 256;
        S.nM2 = NV / 256; S.nN2 = T / 256;
        S.nM3 = TM / 256; S.nN3 = 1024 / 256;
        S.nM4 = 1024 / 256; S.nN4 = TM / 256;
        S.total = S.nM0 * S.nN0 + S.nM1 * S.nN1 + S.nM2 * S.nN2 + S.nM3 * S.nN3 + S.nM4 * S.nN4;
        pg8::MultiPtrs P{H0b, Wgate_t, H0b, WinQK_t, WinV_t, H0b, MEMb, Wmem_t, Wmem_t + (size_t)1024 * 2048, MEMb};
        pg8::EpiBf16Multi E{pg8::EpiBf16{GATES, NG, args.in[I_BGATE], 2, 1.f}, pg8::EpiBf16{QKP, NQK, nullptr, 0, 1.f}, pg8::EpiBf16{VT, T, nullptr, 0, 1.f}, pg8::EpiBf16{MK, 1024, nullptr, 0, 1.f}, pg8::EpiBf16{MVT, TM, nullptr, 0, 1.f},
                             0.125f * att::LOG2E, 0.08838834764831845f * att::LOG2E, 0.0625f * att::LOG2E};
        pg8::gemm_phase<pg8::EpiBf16Multi, pg8::MultiOrder, pg8::MultiPtrs>(lds, g, S, P, E);
        if (IN(2)) GRID_BAR();
        STAMP(2);
    }

    if (IN(2)) {
        phase_attention(lds, args, QKP, VT, MK, MVT, BR, vcu, G, wave, lane);
        if (IN(3)) GRID_BAR();
        STAMP(3);
    }

    if (IN(3)) {
        pg8::Gemm g{BR, Wbr_t, NBR, NBR, T, D, NBR};
        pg8::EpiGate E{GATES, NG, MIXED, D};
        pg8::StaticOrder S; S.init(T, D, G, bx); pg8::SinglePtrs P{g.A, g.Bt};
        pg8::gemm_phase<pg8::EpiGate, pg8::StaticOrder, pg8::SinglePtrs>(lds, g, S, P, E);
        if (IN(4)) GRID_BAR();
        STAMP(4);
    }

    if (IN(4)) {
        pg8::Gemm g{MIXED, Wo_t, 2048, 2048, T, D, 2048}; pg8::EpiResid E{out, D, ALPHA};
        pg8::StaticOrder S; S.init(T, D, G, bx); pg8::SinglePtrs P{g.A, g.Bt};
        pg8::gemm_phase<pg8::EpiResid, pg8::StaticOrder, pg8::SinglePtrs>(lds, g, S, P, E);
        if (IN(5)) GRID_BAR();
        STAMP(5);
    }

    if (IN(5)) {
        for (int m = gw; m < T; m += NGW) ln_row(out + (size_t)m * D, args.in[I_LN1G], args.in[I_LN1B], out + (size_t)m * D, H1b + (size_t)m * D, lane);
        constexpr int NIT = 32 * (NUP / 64) + (DFF / 64) * 32;
        for (int it = gw; it < NIT; it += NGW) {
            int r = it;
            TJOB(args.in[I_WUP], NUP, 2048, NUP, Wup_t)
            TJOB(args.in[I_WDOWN], 2048, DFF, 2048, Wdown_t)
        }
        if (IN(6)) GRID_BAR();
        STAMP(6);
    }

    if (IN(6)) {
        pg8::Gemm g{H1b, Wup_t, 2048, 2048, T, NUP, 2048}; pg8::EpiBf16 E; E.O = U; E.ldc = NUP; E.bias = nullptr; E.act = 0; E.scl = 1.f;
        pg8::StaticOrder S; S.init(T, NUP, G, bx); pg8::SinglePtrs P{g.A, g.Bt};
        pg8::gemm_phase<pg8::EpiBf16, pg8::StaticOrder, pg8::SinglePtrs>(lds, g, S, P, E);
        if (IN(7)) GRID_BAR();
        STAMP(7);
    }

    if (IN(7)) {
        const float* cw = args.in[I_CONVW]; const float* cb = args.in[I_CONVB];
        constexpr int NCH = DFF / 8, RUN = 8, NITEM = (T / RUN) * NCH;
        for (int item = bx * (NWAVES * 64) + tid; item < NITEM; item += G * NWAVES * 64) {
            const int tr = item / NCH, c = item % NCH, t0 = tr * RUN, n0 = c * 8;
            v4u ra[RUN + 2], rb[RUN + 2];
#pragma unroll
            for (int i = 0; i < RUN + 2; ++i) {
                const int t = t0 - 1 + i; const bool zero = (i == 0 && (t0 % SEQ) == 0) || (i == RUN + 1 && ((t0 + RUN) % SEQ) == 0);
                if (zero) { ra[i] = (v4u){0u, 0u, 0u, 0u}; rb[i] = (v4u){0u, 0u, 0u, 0u}; }
                else { ra[i] = *(const GAS v4u*)(U + (size_t)t * NUP + n0); rb[i] = *(const GAS v4u*)(U + (size_t)t * NUP + DFF + n0); }
            }
            float w0[16], w1[16], w2[16], bb[16];
#pragma unroll
            for (int e = 0; e < 8; ++e) { w0[e] = cw[n0 + e]; w1[e] = cw[NUP + n0 + e]; w2[e] = cw[2 * NUP + n0 + e]; bb[e] = cb[n0 + e];
                w0[8 + e] = cw[DFF + n0 + e]; w1[8 + e] = cw[NUP + DFF + n0 + e]; w2[8 + e] = cw[2 * NUP + DFF + n0 + e]; bb[8 + e] = cb[DFF + n0 + e]; }
#define UNPK(dst, a_, b_) do { dst[0] = bflo(a_.x); dst[1] = bfhi(a_.x); dst[2] = bflo(a_.y); dst[3] = bfhi(a_.y); dst[4] = bflo(a_.z); dst[5] = bfhi(a_.z); dst[6] = bflo(a_.w); dst[7] = bfhi(a_.w); \
                dst[8] = bflo(b_.x); dst[9] = bfhi(b_.x); dst[10] = bflo(b_.y); dst[11] = bfhi(b_.y); dst[12] = bflo(b_.z); dst[13] = bfhi(b_.z); dst[14] = bflo(b_.w); dst[15] = bfhi(b_.w); } while (0)
#pragma unroll
            for (int tt = 0; tt < RUN; ++tt) {
                float prev[16], cur[16], nxt[16];
                UNPK(prev, ra[tt], rb[tt]); UNPK(cur, ra[tt + 1], rb[tt + 1]); UNPK(nxt, ra[tt + 2], rb[tt + 2]);
                float o[8];
#pragma unroll
                for (int e = 0; e < 8; ++e) { const float val = prev[e] * w0[e] + cur[e] * w1[e] + nxt[e] * w2[e] + bb[e];
                    const float gt = prev[8 + e] * w0[8 + e] + cur[8 + e] * w1[8 + e] + nxt[8 + e] * w2[8 + e] + bb[8 + e]; o[e] = gelu_tanh(gt) * val; }
                *(GAS v4u*)(ACT + (size_t)(t0 + tt) * DFF + n0) = (v4u){pk2(o[0], o[1]), pk2(o[2], o[3]), pk2(o[4], o[5]), pk2(o[6], o[7])};
            }
#undef UNPK
        }
        if (IN(8)) GRID_BAR();
        STAMP(8);
    }

    if (IN(8)) {
        pg8::Gemm g{ACT, Wdown_t, DFF, DFF, T, D, DFF}; pg8::EpiResid E{out, D, ALPHA};
        pg8::StaticOrder S; S.init(T, D, G, bx); pg8::SinglePtrs P{g.A, g.Bt};
        pg8::gemm_phase<pg8::EpiResid, pg8::StaticOrder, pg8::SinglePtrs>(lds, g, S, P, E);
        if (IN(9)) GRID_BAR();
        STAMP(9);
    }

    if (IN(9)) {
        for (int m = gw; m < T; m += NGW) ln_row(out + (size_t)m * D, args.in[I_LN2G], args.in[I_LN2B], out + (size_t)m * D, nullptr, lane);
#ifdef PROBE_TS
        GRID_BAR(); STAMP(10);
        if (bx == 0 && tid == 0) {
            const unsigned long long* tsr = (const unsigned long long*)(ws + 32768);
            const unsigned long long da = tsr[PROBE_A + 1] - tsr[PROBE_A], db = tsr[PROBE_B + 1] - tsr[PROBE_B];
            const unsigned long long spin = 8ull * da + 8ull * db;
            const unsigned long long t0 = __builtin_amdgcn_s_memrealtime();
            while (__builtin_amdgcn_s_memrealtime() - t0 < spin) __builtin_amdgcn_s_sleep(8);
        }
#endif
    }
#undef IN
#undef TJOB
#undef TJOBP
#undef GRID_BAR
}

extern "C" void kernel_launch(void* const* d_in, const int* in_sizes, int n_in, void* d_out, int out_size, void* d_ws, size_t ws_size, hipStream_t stream) {
    static int grid = 0;
    if (grid == 0) {
        if (n_in != 25 || in_sizes[0] != T * D || out_size != T * D || ws_size < WS_END) { fprintf(stderr, "kernel_launch: unexpected shapes (n_in %d, in0 %d, out %d, ws %zu < %zu)\n", n_in, n_in > 0 ? in_sizes[0] : -1, out_size, ws_size, (size_t)WS_END); grid = -1; return; }
        int dev = 0, cus = 0, per_cu = 0;
        if (hipGetDevice(&dev) != hipSuccess || hipDeviceGetAttribute(&cus, hipDeviceAttributeMultiprocessorCount, dev) != hipSuccess) { fprintf(stderr, "kernel_launch: device query failed\n"); grid = -1; return; }
        if (hipFuncSetAttribute((const void*)mega_fwd, hipFuncAttributeMaxDynamicSharedMemorySize, LDS_BYTES) != hipSuccess) { fprintf(stderr, "kernel_launch: hipFuncSetAttribute failed\n"); grid = -1; return; }
        if (hipOccupancyMaxActiveBlocksPerMultiprocessor(&per_cu, (const void*)mega_fwd, NWAVES * 64, LDS_BYTES) != hipSuccess || per_cu < 1)
            fprintf(stderr, "kernel_launch: note: occupancy query reports %d workgroups per CU\n", per_cu);
        (void)hipGetLastError();
        grid = cus;
    }
    if (grid < 0) return;
    if (hipMemsetAsync((char*)d_ws + WS_CTL, 0, CTL_ZERO_BYTES, stream) != hipSuccess) { fprintf(stderr, "kernel_launch: memset failed\n"); return; }
    Args a{};
    for (int i = 0; i < 25; ++i) a.in[i] = (const float*)d_in[i];
    a.out = (float*)d_out; a.ws = (unsigned char*)d_ws;
    if (N_LAUNCHES == 1) { a.ph_lo = 0; a.ph_hi = N_PHASES; hipLaunchKernelGGL(mega_fwd, dim3(grid), dim3(NWAVES * 64), LDS_BYTES, stream, a); }
    else for (int li = 0; li < N_PHASES; ++li) { a.ph_lo = li; a.ph_hi = li + 1; hipLaunchKernelGGL(mega_fwd, dim3(grid), dim3(NWAVES * 64), LDS_BYTES, stream, a); }
    const hipError_t le = hipPeekAtLastError();
    if (le != hipSuccess) fprintf(stderr, "kernel_launch: launch failed: %s\n", hipGetErrorName(le));
}
```

```cpp
#define ATT_QHOLD_MAX 256
#include <hip/hip_runtime.h>
#include <cstdio>
#include <cstdint>
#include <cmath>
namespace pg8 {
#define PG8_LAS __attribute__((address_space(3)))
typedef unsigned short bf16_t;
typedef short bf16x8 __attribute__((ext_vector_type(8)));
typedef float f32x4 __attribute__((ext_vector_type(4)));
typedef float f32x2 __attribute__((ext_vector_type(2)));
typedef unsigned u32x4 __attribute__((ext_vector_type(4)));
typedef unsigned u32x2 __attribute__((ext_vector_type(2)));
constexpr int BM = 256, BK = 64, HALF = 128, HTB = HALF * BK * 2  , STAGE_BYTES = 8 * HTB, NXCD = 8, WGM = 8;

__host__ __device__ __forceinline__ int lds_byte(int r, int c) { const int st = (r >> 4) * 2 + (c >> 5), rr = r & 15, cc = c & 31, ob = rr * 64 + cc * 2; return st * 1024 + (ob ^ (((ob >> 9) & 1) << 5)); }
__host__ __device__ __forceinline__ void stage_rc(int b, int& R, int& C) { const int st = b / 1024, sb = b % 1024, swz = sb ^ (((sb >> 9) & 1) << 5); R = (st >> 1) * 16 + swz / 64; C = (st & 1) * 32 + (swz % 64) / 2; }
__host__ __device__ __forceinline__ int perm32(int rho) { const int n = rho >> 4, i = rho & 15; return 8 * (i >> 2) + 4 * n + (i & 3); }

struct Unit { int pm, pn, job; };
struct Gemm { const bf16_t* A; const bf16_t* Bt; int lda, ldb, M, N, K; };

struct StaticOrder {
    int nM, nN, nwg, G, c;
    __host__ __device__ void init(int M, int N, int G_, int c_) { nM = M / BM; nN = N / BM; nwg = nM * nN; G = G_; c = c_; }
    __host__ __device__ bool next(int i, Unit& u) const {
        const long L = (long)i * G + c; if (L >= nwg) return false;
        int wgid = (int)L; { const int q = nwg / NXCD, r = nwg % NXCD, xcd = wgid % NXCD, off = wgid / NXCD; wgid = (xcd < r ? xcd * (q + 1) : r * (q + 1) + (xcd - r) * q) + off; }
        const int nig = WGM * nN, gid = wgid / nig, fm = gid * WGM, gsz = (nM - fm) < WGM ? (nM - fm) : WGM;
        u.pm = fm + ((wgid % nig) % gsz); u.pn = (wgid % nig) / gsz; u.job = 0; return true;
    }
};
struct MultiOrder {
    int nM0, nN0, nM1, nN1, nM2, nN2, nM3, nN3, nM4, nN4, total, G, c;
    __host__ __device__ bool next(int i, Unit& u) const {
        const long L = (long)i * G + c; if (L >= total) return false;
        int wgid = (int)L; { const int q = total / NXCD, r = total % NXCD, xcd = wgid % NXCD, off = wgid / NXCD; wgid = (xcd < r ? xcd * (q + 1) : r * (q + 1) + (xcd - r) * q) + off; }
        int j = 0, m_ = nM0, n_ = nN0;
        if (wgid >= m_ * n_) { wgid -= m_ * n_; j = 1; m_ = nM1; n_ = nN1;
            if (wgid >= m_ * n_) { wgid -= m_ * n_; j = 2; m_ = nM2; n_ = nN2;
                if (wgid >= m_ * n_) { wgid -= m_ * n_; j = 3; m_ = nM3; n_ = nN3;
                    if (wgid >= m_ * n_) { wgid -= m_ * n_; j = 4; m_ = nM4; n_ = nN4; } } } }
        const int nig = WGM * n_, gid = wgid / nig, fm = gid * WGM, gsz = (m_ - fm) < WGM ? (m_ - fm) : WGM;
        u.pm = fm + ((wgid % nig) % gsz); u.pn = (wgid % nig) / gsz; u.job = j; return true;
    }
};

__device__ __forceinline__ unsigned cvt_pk_bf16(float lo, float hi) { unsigned r; asm volatile("v_cvt_pk_bf16_f32 %0, %1, %2" : "=v"(r) : "v"(lo), "v"(hi)); return r; }
__device__ __forceinline__ float bf_lo(unsigned w) { return __uint_as_float(w << 16); }
__device__ __forceinline__ float bf_hi(unsigned w) { return __uint_as_float(w & 0xffff0000u); }
__device__ __forceinline__ float sigmoidf_(float z) { return __builtin_amdgcn_rcpf(1.0f + __builtin_amdgcn_exp2f(-1.4426950408889634f * z)); }

struct EpiBf16 {
    static constexpr bool PERM = true, MIDK = false;
    bf16_t* O; int ldc; const float* bias; int act; float scl;
    __device__ __forceinline__ void operator()(const f32x4 (&acc)[2][2][4][2], const Unit& u, int wr, int wc, int fr, int fq) const {
        const int row0 = u.pm * BM + wr * 64 + fr; const int col0 = u.pn * BM + wc * 32 + 8 * fq;
        f32x4 bv[2][2];
#pragma unroll
        for (int bj = 0; bj < 2; ++bj)
#pragma unroll
            for (int n = 0; n < 2; ++n) bv[bj][n] = bias ? *(const f32x4*)(bias + col0 + bj * HALF + 4 * n) : (f32x4){0.f, 0.f, 0.f, 0.f};
#pragma unroll
        for (int ai = 0; ai < 2; ++ai)
#pragma unroll
            for (int m = 0; m < 4; ++m) { bf16_t* rowp = O + (size_t)(row0 + ai * HALF + m * 16) * ldc + col0;
#pragma unroll
                for (int bj = 0; bj < 2; ++bj) { f32x4 v0 = acc[ai][bj][m][0] + bv[bj][0], v1 = acc[ai][bj][m][1] + bv[bj][1];
                    if (act == 2) {
#pragma unroll
                        for (int e = 0; e < 4; ++e) { v0[e] = sigmoidf_(v0[e]); v1[e] = sigmoidf_(v1[e]); } }
                    v0 = v0 * scl; v1 = v1 * scl;
                    u32x4 w; w.x = cvt_pk_bf16(v0[0], v0[1]); w.y = cvt_pk_bf16(v0[2], v0[3]); w.z = cvt_pk_bf16(v1[0], v1[1]); w.w = cvt_pk_bf16(v1[2], v1[3]);
                    *(u32x4*)(rowp + bj * HALF) = w; } }
    }
};

struct EpiBf16Multi {
    static constexpr bool PERM = true, MIDK = false;
    EpiBf16 e0, e1, e2, e3, e4; float qs_diff, qs_win, qs_mem;
    __device__ __forceinline__ void operator()(const f32x4 (&acc)[2][2][4][2], const Unit& u, int wr, int wc, int fr, int fq) const {
        const int j = u.job; EpiBf16 x;
        x.O = j == 1 ? e1.O : j == 2 ? e2.O : j == 3 ? e3.O : j == 4 ? e4.O : e0.O;
        x.ldc = j == 1 ? e1.ldc : j == 2 ? e2.ldc : j == 3 ? e3.ldc : j == 4 ? e4.ldc : e0.ldc;
        x.bias = j == 1 ? e1.bias : j == 2 ? e2.bias : j == 3 ? e3.bias : j == 4 ? e4.bias : e0.bias;
        x.act = j == 1 ? e1.act : j == 2 ? e2.act : j == 3 ? e3.act : j == 4 ? e4.act : e0.act;
        x.scl = 1.0f;
        if (j == 1) { const int pn = u.pn; x.scl = pn < 4 ? qs_diff : (pn >= 8 && pn < 12) ? qs_win : pn >= 13 ? qs_mem : 1.0f; }
        x(acc, u, wr, wc, fr, fq);
    }
};

struct EpiGate {
    static constexpr bool PERM = true, MIDK = true;
    const bf16_t* G; int ldg; bf16_t* O; int ldo;
    __device__ __forceinline__ void mid(f32x4 (&acc)[2][2][4][2], const Unit& u, int seg  , int wr, int wc, int fr, int fq) const {
        const char* gbase = (const char*)G + (size_t)(seg - 1) * 4096;
        const unsigned off0 = (unsigned)((u.pm * BM + wr * 64 + fr) * ldg + u.pn * BM + wc * 32 + 8 * fq) * 2u, rstep = (unsigned)ldg * 32u;
#pragma unroll
        for (int ai = 0; ai < 2; ++ai)
#pragma unroll
            for (int m = 0; m < 4; ++m) { const unsigned off = off0 + (unsigned)(ai * 8 + m) * rstep;
                u32x4 ga[2], gb[2];
#pragma unroll
                for (int bj = 0; bj < 2; ++bj) { ga[bj] = *(const u32x4*)(gbase + off + bj * 256); gb[bj] = *(const u32x4*)(gbase + off + 4096 + bj * 256); }
#pragma unroll
                for (int bj = 0; bj < 2; ++bj)
#pragma unroll
                    for (int e = 0; e < 4; ++e) {
                        const float r0 = bf_lo(ga[bj][e]) * __builtin_amdgcn_rcpf(fmaxf(bf_lo(gb[bj][e]), 1e-30f)), r1 = bf_hi(ga[bj][e]) * __builtin_amdgcn_rcpf(fmaxf(bf_hi(gb[bj][e]), 1e-30f));
                        acc[ai][bj][m][e >> 1][2 * (e & 1)] *= r0; acc[ai][bj][m][e >> 1][2 * (e & 1) + 1] *= r1; }
                asm volatile("" ::: "memory"); }
    }
    __device__ __forceinline__ void operator()(const f32x4 (&acc)[2][2][4][2], const Unit& u, int wr, int wc, int fr, int fq) const {
        const int row0 = u.pm * BM + wr * 64 + fr, col0 = u.pn * BM + wc * 32 + 8 * fq;
#pragma unroll
        for (int ai = 0; ai < 2; ++ai)
#pragma unroll
            for (int m = 0; m < 4; ++m) { const size_t row = (size_t)(row0 + ai * HALF + m * 16);
#pragma unroll
                for (int bj = 0; bj < 2; ++bj) { const u32x4 g = *(const u32x4*)(G + row * ldg + 2 * 2048 + col0 + bj * HALF);
                    const f32x4 v0 = acc[ai][bj][m][0], v1 = acc[ai][bj][m][1];
                    u32x4 w; w.x = cvt_pk_bf16(v0[0] * bf_lo(g.x), v0[1] * bf_hi(g.x)); w.y = cvt_pk_bf16(v0[2] * bf_lo(g.y), v0[3] * bf_hi(g.y));
                    w.z = cvt_pk_bf16(v1[0] * bf_lo(g.z), v1[1] * bf_hi(g.z)); w.w = cvt_pk_bf16(v1[2] * bf_lo(g.w), v1[3] * bf_hi(g.w));
                    *(u32x4*)(O + row * ldo + col0 + bj * HALF) = w; } }
    }
};

struct EpiResid {
    static constexpr bool PERM = false, MIDK = false;
    float* C; int ldc; float alpha;
    __device__ __forceinline__ void operator()(const f32x4 (&acc)[2][2][4][2], const Unit& u, int wr, int wc, int fr, int fq) const {
        const int row0 = u.pm * BM + wr * 64 + fr, col0 = u.pn * BM + wc * 32 + 4 * fq;
#pragma unroll
        for (int ai = 0; ai < 2; ++ai)
#pragma unroll
            for (int m = 0; m < 4; ++m) { float* rowp = C + (size_t)(row0 + ai * HALF + m * 16) * ldc + col0;
#pragma unroll
                for (int bj = 0; bj < 2; ++bj)
#pragma unroll
                    for (int n = 0; n < 2; ++n) { f32x4* p = (f32x4*)(rowp + bj * HALF + n * 16); *p = *p * alpha + acc[ai][bj][m][n]; } }
    }
};

struct SinglePtrs { const bf16_t* A; const bf16_t* Bt;
    __device__ __forceinline__ void bases(const Unit& u, size_t tA, size_t tB, const char*& a, const char*& b) const { a = (const char*)A + (size_t)u.pm * tA; b = (const char*)Bt + (size_t)u.pn * tB; } };
struct MultiPtrs { const bf16_t *A0, *B0, *A1, *B1, *A2, *B2, *A3, *B3, *A4, *B4;
    __device__ __forceinline__ void bases(const Unit& u, size_t tA, size_t tB, const char*& a, const char*& b) const {
        const int j = u.job;
        const bf16_t* pa = j == 1 ? A1 : j == 2 ? A2 : j == 3 ? A3 : j == 4 ? A4 : A0;
        const bf16_t* pb = j == 1 ? B1 : j == 2 ? B2 : j == 3 ? B3 : j == 4 ? B4 : B0;
        a = (const char*)pa + (size_t)u.pm * tA; b = (const char*)pb + (size_t)u.pn * tB; } };

template <class Epi, class Sched, class Ptrs, bool ALIGN_EPI = true>
__device__ __forceinline__ void gemm_phase(PG8_LAS unsigned char* lds, const Gemm g, const Sched& S, const Ptrs& P, const Epi& E) {
    const int tid = threadIdx.x, wid = __builtin_amdgcn_readfirstlane(tid >> 6), lane = tid & 63, wr = wid >> 2, wc = wid & 3, fr = lane & 15, fq = lane >> 4;
    const int K = g.K, nt = K / BK;
    unsigned voffA[2], voffB[2];
#pragma unroll
    for (int i = 0; i < 2; ++i) { int R, C; stage_rc(tid * 16 + i * 8192, R, C); const int Rb = Epi::PERM ? ((R & ~31) + perm32(R & 31)) : R;
        voffA[i] = (unsigned)(R * g.lda + C) * 2u; voffB[i] = (unsigned)(Rb * g.ldb + C) * 2u; }
    const size_t kstep = (size_t)(BK * 2);
    const size_t hA = (size_t)HALF * g.lda * 2, hB = (size_t)HALF * g.ldb * 2;
    const size_t tA = 2 * hA, tB = 2 * hB;
    const unsigned ldsw = (unsigned)wid * 1024u;
    const int aoff = lds_byte(wr * 64 + fr, fq * 8), boff = lds_byte(wc * 32 + fr, fq * 8);
#define PG8_SA(b, h) (((b) * 2 + (h)) * HTB)
#define PG8_SB(b, h) ((4 + (b) * 2 + (h)) * HTB)
#define PG8_STAGE(bufoff, gbase, voff) do { _Pragma("unroll") for (int _i = 0; _i < 2; ++_i) \
        __builtin_amdgcn_global_load_lds((const unsigned*)((const char*)(gbase) + (voff)[_i]), (PG8_LAS unsigned*)(lds + (bufoff) + ldsw + _i * 8192), 16, 0, 0); } while (0)
#define PG8_LDA(dst, b, h) do { _Pragma("unroll") for (int m = 0; m < 4; ++m) _Pragma("unroll") for (int k = 0; k < 2; ++k) dst[m][k] = *(const PG8_LAS bf16x8*)(lds + PG8_SA(b, h) + aoff + m * 2048 + k * 1024); } while (0)
#define PG8_LDB(dst, b, h) do { _Pragma("unroll") for (int n = 0; n < 2; ++n) _Pragma("unroll") for (int k = 0; k < 2; ++k) dst[n][k] = *(const PG8_LAS bf16x8*)(lds + PG8_SB(b, h) + boff + n * 2048 + k * 1024); } while (0)
#define PG8_MMA(ai, bj, At, Bt) do { __builtin_amdgcn_s_setprio(1); _Pragma("unroll") for (int m = 0; m < 4; ++m) _Pragma("unroll") for (int n = 0; n < 2; ++n) _Pragma("unroll") for (int k = 0; k < 2; ++k) \
        acc[ai][bj][m][n] = __builtin_amdgcn_mfma_f32_16x16x32_bf16(Bt[n][k], At[m][k], acc[ai][bj][m][n], 0, 0, 0); __builtin_amdgcn_s_setprio(0); } while (0)
#define PG8_WAIT_V(n) asm volatile("s_waitcnt vmcnt(" #n ")" ::: "memory")
#define PG8_WAIT_L(n) asm volatile("s_waitcnt lgkmcnt(" #n ")" ::: "memory")
#define PG8_BAR __builtin_amdgcn_s_barrier()
#define PG8_SCHED __builtin_amdgcn_sched_barrier(0)
    Unit cur, nxt; int ui = 0;
    if (!S.next(0, cur)) return;
    f32x4 acc[2][2][4][2];
#pragma unroll
    for (int a = 0; a < 2; ++a)
#pragma unroll
        for (int b = 0; b < 2; ++b)
#pragma unroll
            for (int m = 0; m < 4; ++m)
#pragma unroll
                for (int n = 0; n < 2; ++n) acc[a][b][m][n] = (f32x4){0.f, 0.f, 0.f, 0.f};
    bf16x8 At[4][2], B0[2][2], B1[2][2];
    const char* cA; const char* cB; P.bases(cur, tA, tB, cA, cB);
    PG8_STAGE(PG8_SB(0, 0), cB, voffB); PG8_STAGE(PG8_SB(0, 1), cB + hB, voffB); PG8_STAGE(PG8_SA(0, 0), cA, voffA); PG8_STAGE(PG8_SA(0, 1), cA + hA, voffA);
    if (wr == 1) PG8_BAR;
    PG8_WAIT_V(2); PG8_BAR;
    PG8_STAGE(PG8_SB(1, 0), cB + kstep, voffB); PG8_STAGE(PG8_SA(1, 0), cA + kstep, voffA); PG8_STAGE(PG8_SB(1, 1), cB + hB + kstep, voffB);
    PG8_WAIT_V(6); PG8_BAR;
    for (;;) {
        const bool has_next = S.next(ui + 1, nxt);
        const char* nA = cA; const char* nB = cB; if (has_next) P.bases(nxt, tA, tB, nA, nB);
        for (int t = 0; t < nt; t += 2) {
            const bool last = (t == nt - 2);
            const char* a1 = cA + (size_t)(t + 1) * kstep;
            const char* a2 = last ? nA : cA + (size_t)(t + 2) * kstep; const char* b2 = last ? nB : cB + (size_t)(t + 2) * kstep;
            const char* a3 = a2 + kstep; const char* b3 = b2 + kstep;
            if constexpr (Epi::MIDK) { if (t == 16 || t == 32) E.mid(acc, cur, t >> 4, wr, wc, fr, fq); }
            PG8_LDB(B0, 0, 0); PG8_LDB(B1, 0, 1); PG8_SCHED; PG8_LDA(At, 0, 0); PG8_STAGE(PG8_SA(1, 1), a1 + hA, voffA);
            PG8_WAIT_V(8); PG8_WAIT_L(0); PG8_BAR; PG8_MMA(0, 0, At, B0); PG8_MMA(0, 1, At, B1); PG8_BAR; PG8_SCHED;
            PG8_LDA(At, 0, 1); PG8_STAGE(PG8_SB(0, 0), b2, voffB); PG8_STAGE(PG8_SB(0, 1), b2 + hB, voffB); PG8_STAGE(PG8_SA(0, 0), a2, voffA);
            PG8_WAIT_V(8); PG8_WAIT_L(0); PG8_BAR; PG8_MMA(1, 0, At, B0); PG8_MMA(1, 1, At, B1); PG8_BAR; PG8_SCHED;
            PG8_LDB(B0, 1, 0); PG8_LDB(B1, 1, 1); PG8_SCHED; PG8_LDA(At, 1, 0); PG8_STAGE(PG8_SA(0, 1), a2 + hA, voffA);
            PG8_WAIT_V(8); PG8_WAIT_L(0); PG8_BAR; PG8_MMA(0, 0, At, B0); PG8_MMA(0, 1, At, B1); PG8_BAR; PG8_SCHED;
            PG8_LDA(At, 1, 1); PG8_STAGE(PG8_SB(1, 0), b3, voffB); PG8_STAGE(PG8_SB(1, 1), b3 + hB, voffB); PG8_STAGE(PG8_SA(1, 0), a3, voffA);
            PG8_WAIT_V(8); PG8_WAIT_L(0); PG8_BAR; PG8_MMA(1, 0, At, B0); PG8_MMA(1, 1, At, B1); PG8_BAR; PG8_SCHED;
        }
        if constexpr (ALIGN_EPI) { if (wr == 0) PG8_BAR; }
        E(acc, cur, wr, wc, fr, fq);
        if (!has_next) break;
#pragma unroll
        for (int a = 0; a < 2; ++a)
#pragma unroll
            for (int b = 0; b < 2; ++b)
#pragma unroll
                for (int m = 0; m < 4; ++m)
#pragma unroll
                    for (int n = 0; n < 2; ++n) acc[a][b][m][n] = (f32x4){0.f, 0.f, 0.f, 0.f};
        cur = nxt; cA = nA; cB = nB; ++ui;
        if constexpr (ALIGN_EPI) { if (wr == 1) PG8_BAR; }
    }
    PG8_WAIT_V(0);
    if constexpr (!ALIGN_EPI) { if (wr == 0) PG8_BAR; }
    PG8_BAR;
#undef PG8_SA
#undef PG8_SB
#undef PG8_STAGE
#undef PG8_LDA
#undef PG8_LDB
#undef PG8_MMA
#undef PG8_WAIT_V
#undef PG8_WAIT_L
#undef PG8_BAR
#undef PG8_SCHED
}
}
#ifndef ATT_QHOLD_MAX
#define ATT_QHOLD_MAX 128
#endif
namespace att {
#define ATT_LAS __attribute__((address_space(3)))
typedef unsigned short bf16_t;
typedef short bf16x8 __attribute__((ext_vector_type(8)));
typedef float f32x16 __attribute__((ext_vector_type(16)));
typedef unsigned u32x4 __attribute__((ext_vector_type(4)));
typedef unsigned u32x2 __attribute__((ext_vector_type(2)));
constexpr float LOG2E = 1.4426950408889634f;
constexpr float NEGBIG = -1e30f;
constexpr int VROW = 136;
constexpr int BIAS_OFF = 120 * 1024;
constexpr int BIAS_STRIDE = 1040;
constexpr int SCR_OFF = 123 * 1024;
constexpr int XCH_OFF = 0;

__device__ __forceinline__ unsigned pk_bf16(float lo, float hi) { unsigned r; asm volatile("v_cvt_pk_bf16_f32 %0, %1, %2" : "=v"(r) : "v"(lo), "v"(hi)); return r; }

__device__ __forceinline__ int t5_bucket(int rel) {
    const int n = rel < 0 ? -rel : rel; const int ret = rel > 0 ? 16 : 0;
    const float nf = (float)(n < 1 ? 1 : n);
    int large = 8 + (int)(logf(nf / 8.0f) / 2.7725887222397811f * 8.0f);
    large = large < 15 ? large : 15;
    return ret + (n < 8 ? n : large);
}
__device__ __forceinline__ void fill_bias(ATT_LAS unsigned char* lds, int t, const float* rel_table, int col) {
    ATT_LAS float* tab = (ATT_LAS float*)(lds + BIAS_OFF + t * BIAS_STRIDE);
    for (int i = threadIdx.x; i < 257; i += 512) tab[i] = rel_table[t5_bucket(i - 128) * 16 + col] * LOG2E;
}

struct Desc {
    const bf16_t* Qw; int ldq;
    const bf16_t* K;  int ldk;
    const bf16_t* Vt; int ldv;
    bf16_t* Ow; int ldo;
    int qpos0;
    int kt0, kt1;
    int btab;
    int kcol0;
    float sink2;
    float lam;
    const float* subg;
};

template <int KW, int DQK, bool BIAS, bool WIN, bool DIFF, int THR>
__device__ __forceinline__ void attn_unit(ATT_LAS unsigned char* lds, const Desc& D) {
    constexpr int KROW = KW * 2 + 16, CPR = KW / 8, NKC = 64 * CPR / 512, NDC = DQK / 16;
    constexpr int KBYTES = 64 * KROW, BUFB = KBYTES + 128 * VROW;
    static_assert(2 * BUFB <= BIAS_OFF, "attention LDS map");
    int tid_ = threadIdx.x; asm volatile("" : "+v"(tid_));
    const int tid = tid_, lane = tid & 63, r = lane & 31, h = lane >> 5, wid = __builtin_amdgcn_readfirstlane(tid >> 6);
    constexpr bool QHOLD = (DQK <= ATT_QHOLD_MAX);
    constexpr int NQF = QHOLD ? NDC : 8;
    bf16x8 qf[NQF];
    const char* qb_ = (const char*)D.Qw; const unsigned qo = (unsigned)(r * D.ldq + 8 * h) * 2u;
    if (QHOLD) {
#pragma unroll
      for (int dc = 0; dc < NQF; ++dc) qf[dc] = *(const bf16x8*)(qb_ + qo + 32 * dc); }
    const ATT_LAS float* tab = (const ATT_LAS float*)(lds + BIAS_OFF + D.btab * BIAS_STRIDE);
    ATT_LAS float* scr = (ATT_LAS float*)(lds + SCR_OFF) + wid * 32;
    const int qpos = D.qpos0 + r;
    float bfarL = 0.f, bfarR = 0.f; if (BIAS) { bfarL = tab[0]; bfarR = tab[256]; }
    u32x4 kreg[NKC], vreg[2];
    const char* Kb = (const char*)D.K; const char* Vb = (const char*)D.Vt;
    unsigned koff[NKC], voff[2], klds[NKC], vlds[2];
#pragma unroll
    for (int i = 0; i < NKC; ++i) { const int c = tid + 512 * i, row = c / CPR, cc = c % CPR; koff[i] = (unsigned)(row * D.ldk + cc * 8) * 2u; klds[i] = (unsigned)(row * KROW + cc * 16); }
#pragma unroll
    for (int i = 0; i < 2; ++i) { const int c = tid + 512 * i, row = c >> 3, cc = c & 7; voff[i] = (unsigned)(row * D.ldv + cc * 8) * 2u; vlds[i] = (unsigned)(KBYTES + row * VROW + cc * 16); }
#define ATT_LOAD(kt) do { const char* kb_ = Kb + (size_t)(kt) * 128 * D.ldk; const char* vb_ = Vb + (size_t)(kt) * 128; \
        _Pragma("unroll") for (int i = 0; i < NKC; ++i) kreg[i] = *(const u32x4*)(kb_ + koff[i]); \
        _Pragma("unroll") for (int i = 0; i < 2; ++i) vreg[i] = *(const u32x4*)(vb_ + voff[i]); } while (0)
#define ATT_STORE(boff) do { _Pragma("unroll") for (int i = 0; i < NKC; ++i) *(ATT_LAS u32x4*)(lds + (boff) + klds[i]) = kreg[i]; \
        _Pragma("unroll") for (int i = 0; i < 2; ++i) { ATT_LAS u32x2* p_ = (ATT_LAS u32x2*)(lds + (boff) + vlds[i]); p_[0] = (u32x2){vreg[i].x, vreg[i].y}; p_[1] = (u32x2){vreg[i].z, vreg[i].w}; } } while (0)

    float m = WIN ? D.sink2 : NEGBIG, l = (WIN && h == 0) ? 1.f : 0.f;
    f32x16 o[4];
#pragma unroll
    for (int db = 0; db < 4; ++db) o[db] = (f32x16){};
    ATT_LOAD(D.kt0); ATT_STORE(0); __syncthreads();
    int cur = 0;
    for (int kt = D.kt0; kt < D.kt1; ++kt) {
        if (kt + 1 < D.kt1) ATT_LOAD(kt + 1);
        const int boff = cur * BUFB;
        const int relmin = kt * 64 - (D.qpos0 + 31), relmax = kt * 64 + 63 - D.qpos0;
        const bool active = !WIN || (relmax >= -128 && relmin <= 128);
        if (active) {
            const bool farR = BIAS && relmin >= 91, farL = BIAS && relmax <= -91, need_mask = WIN && (relmin < -128 || relmax > 128);
            const float cinit = farR ? bfarR : (farL ? bfarL : 0.f);
            f32x16 s[2];
#pragma unroll
            for (int hh = 0; hh < 2; ++hh) s[hh] = (f32x16){};
#pragma unroll
            for (int qh_ = 0; qh_ < NDC / NQF; ++qh_) {
                if (!QHOLD) {
#pragma unroll
                    for (int dc = 0; dc < NQF; ++dc) qf[dc] = *(const bf16x8*)(qb_ + qo + 32 * (qh_ * NQF + dc)); }
#pragma unroll
                for (int hh = 0; hh < 2; ++hh)
#pragma unroll
                    for (int dc = 0; dc < NQF; ++dc) { const bf16x8 kf = *(const ATT_LAS bf16x8*)(lds + boff + (32 * hh + r) * KROW + (D.kcol0 + 16 * (qh_ * NQF + dc) + 8 * h) * 2);
                        s[hh] = __builtin_amdgcn_mfma_f32_32x32x16_bf16(kf, qf[dc], s[hh], 0, 0, 0); }
            }
            if (BIAS && !farR && !farL) {
#pragma unroll
                for (int hh = 0; hh < 2; ++hh)
#pragma unroll
                    for (int i = 0; i < 16; ++i) { const int rel = kt * 64 + 32 * hh + (i & 3) + 8 * (i >> 2) + 4 * h - qpos; const int ix = rel < -128 ? -128 : (rel > 128 ? 128 : rel); s[hh][i] += tab[ix + 128]; }
            }
            if (need_mask) {
#pragma unroll
                for (int hh = 0; hh < 2; ++hh)
#pragma unroll
                    for (int i = 0; i < 16; ++i) { const int rel = kt * 64 + 32 * hh + (i & 3) + 8 * (i >> 2) + 4 * h - qpos; if (rel < -128 || rel > 128) s[hh][i] = NEGBIG; }
            }
            float tm = fmaxf(s[0][0], s[1][0]);
#pragma unroll
            for (int i = 1; i < 16; ++i) tm = fmaxf(tm, fmaxf(s[0][i], s[1][i]));
            tm = fmaxf(tm, __shfl_xor(tm, 32)) + cinit;
            if (__any(tm > m + (float)THR)) {
                const float mn = fmaxf(m, tm), f = __builtin_amdgcn_exp2f(m - mn);
                m = mn; l *= f;
                if (h == 0) scr[r] = f;
                asm volatile("s_waitcnt lgkmcnt(0)" ::: "memory");
#pragma unroll
                for (int i = 0; i < 16; ++i) { const float fi = scr[(i & 3) + 8 * (i >> 2) + 4 * h];
#pragma unroll
                    for (int db = 0; db < 4; ++db) o[db][i] *= fi; }
            }
            const float mc = m - cinit;
#pragma unroll
            for (int hh = 0; hh < 2; ++hh) {
                float p[16];
#pragma unroll
                for (int i = 0; i < 16; ++i) { p[i] = __builtin_amdgcn_exp2f(s[hh][i] - mc); l += p[i]; }
#pragma unroll
                for (int ks = 0; ks < 2; ++ks) {
                    u32x4 pw; pw.x = pk_bf16(p[8 * ks + 0], p[8 * ks + 1]); pw.y = pk_bf16(p[8 * ks + 2], p[8 * ks + 3]); pw.z = pk_bf16(p[8 * ks + 4], p[8 * ks + 5]); pw.w = pk_bf16(p[8 * ks + 6], p[8 * ks + 7]);
                    const bf16x8 pf = __builtin_bit_cast(bf16x8, pw);
#pragma unroll
                    for (int db = 0; db < 4; ++db) {
                        const ATT_LAS u32x2* vp = (const ATT_LAS u32x2*)(lds + boff + KBYTES + (32 * db + r) * VROW + (32 * hh + 16 * ks + 4 * h) * 2);
                        const u32x2 v0 = vp[0], v1 = vp[2];
                        const bf16x8 vf = __builtin_bit_cast(bf16x8, (u32x4){v0.x, v0.y, v1.x, v1.y});
                        o[db] = __builtin_amdgcn_mfma_f32_32x32x16_bf16(pf, vf, o[db], 0, 0, 0);
                    }
                }
            }
        }
        if (kt + 1 < D.kt1) ATT_STORE((cur ^ 1) * BUFB);
        __syncthreads();
        cur ^= 1;
    }
    {
        const float lt = l + __shfl_xor(l, 32);
        if (h == 0) scr[r] = 1.0f / lt;
        asm volatile("s_waitcnt lgkmcnt(0)" ::: "memory");
#pragma unroll
        for (int i = 0; i < 16; ++i) { const float fi = scr[(i & 3) + 8 * (i >> 2) + 4 * h];
#pragma unroll
            for (int db = 0; db < 4; ++db) o[db][i] *= fi; }
    }
    if (DIFF) {
        ATT_LAS float* xch = (ATT_LAS float*)(lds + XCH_OFF) + (wid & 3) * 4096 + lane;
        if (wid >= 4) {
#pragma unroll
            for (int db = 0; db < 4; ++db)
#pragma unroll
                for (int i = 0; i < 16; ++i) xch[(db * 16 + i) * 64] = o[db][i];
        }
        __syncthreads();
        if (wid < 4) {
#pragma unroll
            for (int db = 0; db < 4; ++db)
#pragma unroll
                for (int i = 0; i < 16; ++i) o[db][i] -= D.lam * xch[(db * 16 + i) * 64];
            float gain[4];
#pragma unroll
            for (int db = 0; db < 4; ++db) gain[db] = D.subg[32 * db + r] * 0.8f;
#pragma unroll
            for (int i = 0; i < 16; ++i) {
                float ss = 0.f;
#pragma unroll
                for (int db = 0; db < 4; ++db) ss += o[db][i] * o[db][i];
                ss += __shfl_xor(ss, 1); ss += __shfl_xor(ss, 2); ss += __shfl_xor(ss, 4); ss += __shfl_xor(ss, 8); ss += __shfl_xor(ss, 16);
                const float rs = 1.0f / sqrtf(ss * (1.0f / 128.0f) + 1e-5f);
#pragma unroll
                for (int db = 0; db < 4; ++db) o[db][i] = o[db][i] * rs * gain[db];
            }
        }
    }
    if (!DIFF || wid < 4) {
        ATT_LAS unsigned char* stg = lds + (DIFF ? 65536 : 0) + wid * (32 * 272);
#pragma unroll
        for (int i = 0; i < 16; ++i) { const int q = (i & 3) + 8 * (i >> 2) + 4 * h;
#pragma unroll
            for (int db = 0; db < 4; ++db) *(ATT_LAS bf16_t*)(stg + q * 272 + (32 * db + r) * 2) = (bf16_t)(pk_bf16(o[db][i], 0.f) & 0xffffu); }
        asm volatile("s_waitcnt lgkmcnt(0)" ::: "memory");
        char* ob_ = (char*)D.Ow;
#pragma unroll
        for (int i = 0; i < 8; ++i) { const int row = 4 * i + (lane >> 4), ch = lane & 15;
            const u32x4 v = *(const ATT_LAS u32x4*)(stg + row * 272 + ch * 16);
            *(u32x4*)(ob_ + (unsigned)(row * D.ldo) * 2u + ch * 16) = v; }
    }
    __syncthreads();
#undef ATT_LOAD
#undef ATT_STORE
}
}
constexpr int NWAVES = 8;
#ifndef MK_N_LAUNCHES
#define MK_N_LAUNCHES 1
#endif
constexpr int N_PHASES = 10;
constexpr int N_LAUNCHES = MK_N_LAUNCHES;

constexpr int BATCH = 4, SEQ = 2048, D = 2048, T = BATCH * SEQ, NMEM = 256, TM = BATCH * NMEM;
constexpr int IN_W = 5632, NQK = 4352, NV = 1280, NG = 6144, DFF = 5504, NUP = 2 * DFF, NBR = 3072;
constexpr float LN_EPS = 1e-5f;
constexpr float ALPHA = 1.189207115002721f;
constexpr int C_DQ = 0, C_DK = 1024, C_WQ = 2048, C_WK = 3072, C_MQ = 3328;

constexpr size_t MiB = 1u << 20;
constexpr size_t WS_CTL = 0, CTL_ZERO_BYTES = 64 * 1024;
constexpr size_t WS_WBR = 1 * MiB;
constexpr size_t WS_WO = 13 * MiB;
constexpr size_t WS_WINQK = 21 * MiB;
constexpr size_t WS_WINV = 38 * MiB;
constexpr size_t WS_WGATE = 43 * MiB;
constexpr size_t WS_WMEM = 67 * MiB;
constexpr size_t WS_H0B = 75 * MiB;
constexpr size_t WS_MEMB = 107 * MiB;
constexpr size_t WS_QKP = 111 * MiB;
constexpr size_t WS_VT = 179 * MiB;
constexpr size_t WS_MK = 199 * MiB;
constexpr size_t WS_MVT = 201 * MiB;
constexpr size_t WS_GATES = 203 * MiB;
constexpr size_t WS_BR = 299 * MiB;
constexpr size_t WS_MIXED = 21 * MiB;
constexpr size_t WS_H1B = 53 * MiB;
constexpr size_t WS_WUP = 111 * MiB;
constexpr size_t WS_WDOWN = 154 * MiB;
constexpr size_t WS_U = 176 * MiB;
constexpr size_t WS_ACT = 21 * MiB;
constexpr size_t WS_END = 348 * MiB;
constexpr int CW_BAR = 1024;

constexpr int RING_BYTES = 131072, LDSCTL_OFF = RING_BYTES, MISC_OFF = LDSCTL_OFF + 320, LDS_BYTES = 147456;

#define GAS __attribute__((address_space(1)))
#define LAS __attribute__((address_space(3)))
typedef unsigned short bf16;
typedef unsigned v4u __attribute__((ext_vector_type(4)));
typedef unsigned v2u __attribute__((ext_vector_type(2)));
typedef float f32x4 __attribute__((ext_vector_type(4)));
#define LDS_WAIT() asm volatile("s_waitcnt lgkmcnt(0)" ::: "memory")
__device__ __forceinline__ unsigned f2bf(float f) { unsigned u = __builtin_bit_cast(unsigned, f); return (u + 0x7fffu + ((u >> 16) & 1u)) >> 16; }
__device__ __forceinline__ unsigned pk2(float lo, float hi) { return f2bf(lo) | (f2bf(hi) << 16); }
__device__ __forceinline__ float bflo(unsigned w) { return __uint_as_float(w << 16); }
__device__ __forceinline__ float bfhi(unsigned w) { return __uint_as_float(w & 0xffff0000u); }

#define XB_TMO      128
#define XB_XCNT(j)  (256  + 64 * (j))
#define XB_XSUB(j)  (1280 + 64 * (j))
#define XB_XGEN(j)  (2304 + 64 * (j))
#define XB_TOP      3328
#define XB_TOPGEN   3392
#define XCD_BAR_WORDS 3456
#define XB_SPIN_CAP (1u << 20)
__device__ __forceinline__ unsigned xb_ld(unsigned* p)              { return __hip_atomic_load(p, __ATOMIC_RELAXED, __HIP_MEMORY_SCOPE_AGENT); }
__device__ __forceinline__ unsigned xb_add(unsigned* p, unsigned v) { return __hip_atomic_fetch_add(p, v, __ATOMIC_RELAXED, __HIP_MEMORY_SCOPE_AGENT); }
__device__ __forceinline__ unsigned xb_xcc_id() { return (unsigned)__builtin_amdgcn_s_getreg((3 << 11) | 20) & 0xFu; }
#define XB_SPIN(cond, bar) do { unsigned _sp = 0; while (cond) { __builtin_amdgcn_s_sleep(1); \
    if ((++_sp & 255u) == 0u) { if (xb_ld(&(bar)[XB_TMO])) break; if (_sp > XB_SPIN_CAP) { atomicAdd(&(bar)[XB_TMO], 1u); break; } } } } while (0)
struct XcdBarrier { unsigned* bar; unsigned x; volatile LAS unsigned* st; };
__device__ __forceinline__ XcdBarrier xcd_barrier_post(unsigned* bar, volatile LAS unsigned* st) {
    XcdBarrier b; b.bar = bar; b.x = xb_xcc_id(); b.st = st;
    if (threadIdx.x == 0) (void)xb_add(&bar[XB_XCNT(b.x)], 1u);
    return b;
}
__device__ __forceinline__ void xcd_barrier_complete(unsigned* bar, unsigned x, unsigned& nloc, unsigned& nx) {
    const unsigned G = gridDim.x * gridDim.y * gridDim.z;
    unsigned sum, cnt, mine, sp = 0u;
    for (;;) {
        sum = 0u; cnt = 0u; mine = 0u;
#pragma unroll
        for (unsigned j = 0; j < 16; ++j) { const unsigned c = xb_ld(&bar[XB_XCNT(j)]); sum += c; cnt += (c > 0u) ? 1u : 0u; mine = (j == x) ? c : mine; }
        if (sum == G) break;
        __builtin_amdgcn_s_sleep(1);
        if ((++sp & 255u) == 0u) { if (xb_ld(&bar[XB_TMO])) break; if (sp > XB_SPIN_CAP) { atomicAdd(&bar[XB_TMO], 1u); break; } }
    }
    nloc = mine > 0u ? mine : 1u; nx = cnt > 0u ? cnt : 1u;
}
__device__ __forceinline__ void xcd_barrier(const XcdBarrier& b) {
    asm volatile("s_waitcnt vmcnt(0)" ::: "memory");
    __syncthreads();
    if (threadIdx.x == 0) {
        unsigned* bar = b.bar;
        __builtin_amdgcn_s_waitcnt(0);
        unsigned nloc = b.st[0], nx = b.st[1];
        if (nloc == 0u) { xcd_barrier_complete(bar, b.x, nloc, nx); b.st[0] = nloc; b.st[1] = nx; }
        const unsigned old = xb_add(&bar[XB_XSUB(b.x)], 1u);
        const unsigned gen = old / nloc;
        if (old + 1u == (gen + 1u) * nloc) {
            __builtin_amdgcn_fence(__ATOMIC_RELEASE, "agent");
            asm volatile("s_waitcnt vmcnt(0)" ::: "memory");
            const unsigned og = xb_add(&bar[XB_TOP], 1u);
            const unsigned tg = og / nx;
            if (og + 1u == (tg + 1u) * nx) xb_add(&bar[XB_TOPGEN], 1u);
            else XB_SPIN(xb_ld(&bar[XB_TOPGEN]) == tg, bar);
            __builtin_amdgcn_fence(__ATOMIC_ACQUIRE, "agent");
            xb_add(&bar[XB_XGEN(b.x)], 1u);
            asm volatile("s_waitcnt vmcnt(0)" ::: "memory");
        } else {
            XB_SPIN(xb_ld(&bar[XB_XGEN(b.x)]) == gen, bar);
            __builtin_amdgcn_fence(__ATOMIC_ACQUIRE, "agent");
            asm volatile("s_waitcnt vmcnt(0)" ::: "memory");
        }
    }
    __syncthreads();
}

__device__ __forceinline__ float wave_sum(float v) {
#pragma unroll
    for (int o = 1; o < 64; o <<= 1) v += __shfl_xor(v, o);
    return v;
}
__device__ __forceinline__ void transpose_item(const float* W, int ldw, int K, int ncols, bf16* WT, int ldt, int item, int lane) {
    const int nblk = ncols / 64, kb = item / nblk, nb = item % nblk, k0 = 64 * kb + 16 * (lane >> 4), n0 = 64 * nb + 4 * (lane & 15);
    const GAS float* src = (const GAS float*)W + (size_t)k0 * ldw + n0;
    f32x4 v[16];
#pragma unroll
    for (int i = 0; i < 16; ++i) v[i] = *(const GAS f32x4*)(src + (size_t)i * ldw);
#pragma unroll
    for (int j = 0; j < 4; ++j) {
        GAS v4u* dst = (GAS v4u*)(WT + (size_t)(n0 + j) * ldt + k0);
        v4u o0, o1;
        o0.x = pk2(v[0][j], v[1][j]); o0.y = pk2(v[2][j], v[3][j]); o0.z = pk2(v[4][j], v[5][j]); o0.w = pk2(v[6][j], v[7][j]);
        o1.x = pk2(v[8][j], v[9][j]); o1.y = pk2(v[10][j], v[11][j]); o1.z = pk2(v[12][j], v[13][j]); o1.w = pk2(v[14][j], v[15][j]);
        dst[0] = o0; dst[1] = o1;
    }
}
__device__ __forceinline__ void ln_row(const float* xrow, const float* g, const float* b, float* orow, bf16* brow, int lane) {
    const GAS f32x4* xr = (const GAS f32x4*)xrow + lane;
    f32x4 v[8]; float s = 0.f;
#pragma unroll
    for (int j = 0; j < 8; ++j) { v[j] = xr[64 * j]; s += (v[j].x + v[j].y) + (v[j].z + v[j].w); }
    const float mean = wave_sum(s) * (1.f / D); float s2 = 0.f;
#pragma unroll
    for (int j = 0; j < 8; ++j) { v[j] = v[j] - mean; s2 += (v[j].x * v[j].x + v[j].y * v[j].y) + (v[j].z * v[j].z + v[j].w * v[j].w); }
    const float rstd = 1.f / sqrtf(wave_sum(s2) * (1.f / D) + LN_EPS);
#pragma unroll
    for (int j = 0; j < 8; ++j) {
        const f32x4 gg = ((const GAS f32x4*)g)[lane + 64 * j], bb = ((const GAS f32x4*)b)[lane + 64 * j];
        const f32x4 y = v[j] * rstd * gg + bb;
        if (orow) ((GAS f32x4*)orow)[lane + 64 * j] = y;
        if (brow) ((GAS v2u*)brow)[lane + 64 * j] = (v2u){pk2(y.x, y.y), pk2(y.z, y.w)};
    }
}
__device__ __forceinline__ float gelu_tanh(float x) {
    const float z = 1.5957691216057308f * (x + 0.044715f * x * x * x);
    return x * __builtin_amdgcn_rcpf(1.0f + __builtin_amdgcn_exp2f(-1.4426950408889634f * z));
}
struct Args { const float* in[25]; float* out; unsigned char* ws; int ph_lo, ph_hi; };
enum { I_X = 0, I_MEM, I_LNG, I_LNB, I_REL, I_WIN, I_WMEM, I_LQ1, I_LK1, I_LQ2, I_LK2, I_SUBG, I_SINK, I_WGATE, I_BGATE, I_WBR, I_WO, I_LN1G, I_LN1B, I_WUP, I_CONVW, I_CONVB, I_WDOWN, I_LN2G, I_LN2B };

#ifdef PROBE_TS
#define ATT_STAMP(k) do { if (blockIdx.x == 0 && threadIdx.x == 0) ((unsigned long long*)(args.ws + 32768))[k] = __builtin_amdgcn_s_memrealtime(); } while (0)
#else
#define ATT_STAMP(k) do {} while (0)
#endif
#ifndef ATT_THR
#define ATT_THR 8
#endif
__device__ __forceinline__ void phase_attention(LAS unsigned char* lds, const Args& args, const bf16* QKP, const bf16* VT, const bf16* MK, const bf16* MVT, bf16* BR, int vcu, int G, int wave, int lane) {
        const float* rel_table = args.in[I_REL];
        float lam;
        { const float s1 = wave_sum(args.in[I_LQ1][lane] * args.in[I_LK1][lane]), s2 = wave_sum(args.in[I_LQ2][lane] * args.in[I_LK2][lane]); lam = expf(s1) - expf(s2) + 0.2f; }
        ATT_STAMP(11);
        for (int u = 2 * vcu; u < 512; u += 2 * G)
#pragma unroll 1
          for (int j = 0; j < 2; ++j) {
            const int uu = u + j, b = uu >> 7, h = (uu >> 4) & 7, qb = uu & 15, map = wave >> 2;
            att::fill_bias(lds, 0, rel_table, h); __syncthreads();
            att::Desc d; const size_t row0 = (size_t)b * SEQ + qb * 128 + (wave & 3) * 32;
            d.Qw = QKP + row0 * NQK + C_DQ + h * 128 + map * 64; d.ldq = NQK; d.K = QKP + (size_t)b * SEQ * NQK + C_DK + h * 128; d.ldk = NQK;
            d.Vt = VT + (size_t)(h * 128) * T + (size_t)b * SEQ; d.ldv = T; d.Ow = BR + row0 * NBR + h * 128; d.ldo = NBR;
            d.qpos0 = qb * 128 + (wave & 3) * 32; d.kt0 = 0; d.kt1 = SEQ / 64; d.btab = 0; d.kcol0 = map * 64; d.sink2 = 0.f; d.lam = lam; d.subg = args.in[I_SUBG];
#ifndef SKIP_A
            att::attn_unit<128, 64, true, false, true, ATT_THR>(lds, d);
#endif
        }
        ATT_STAMP(12);
        for (int u = vcu; u < 256; u += G) {
            const int b = u >> 6, kvh = (u >> 5) & 1, qb = (u >> 1) & 15, pair = u & 1; const int qh = kvh * 4 + pair * 2 + (wave >> 2), qsub = wave & 3;
            att::fill_bias(lds, 0, rel_table, 8 + kvh * 4 + pair * 2); att::fill_bias(lds, 1, rel_table, 8 + kvh * 4 + pair * 2 + 1); __syncthreads();
            att::Desc d; const size_t row0 = (size_t)b * SEQ + qb * 128 + qsub * 32;
            d.Qw = QKP + row0 * NQK + C_WQ + qh * 128; d.ldq = NQK; d.K = QKP + (size_t)b * SEQ * NQK + C_WK + kvh * 128; d.ldk = NQK;
            d.Vt = VT + (size_t)(1024 + kvh * 128) * T + (size_t)b * SEQ; d.ldv = T; d.Ow = BR + row0 * NBR + 1024 + qh * 128; d.ldo = NBR;
            d.qpos0 = qb * 128 + qsub * 32; d.kt0 = (2 * qb - 2) < 0 ? 0 : (2 * qb - 2); d.kt1 = (2 * qb + 4) > SEQ / 64 ? SEQ / 64 : (2 * qb + 4);
            d.btab = wave >> 2; d.kcol0 = 0; d.sink2 = args.in[I_SINK][qh] * att::LOG2E; d.lam = 0.f; d.subg = nullptr;
#ifndef SKIP_B
            att::attn_unit<128, 128, true, true, false, ATT_THR>(lds, d);
#endif
        }
        ATT_STAMP(13);
        for (int u = vcu; u < 256; u += G) {
            const int b = u >> 6, h = (u >> 4) & 3, qb = (u >> 1) & 7, half = u & 1;
            att::Desc d; const size_t row0 = (size_t)b * SEQ + qb * 256 + wave * 32;
            d.Qw = QKP + row0 * NQK + C_MQ + h * 256; d.ldq = NQK; d.K = MK + (size_t)(b * NMEM) * 1024 + h * 256; d.ldk = 1024;
            d.Vt = MVT + (size_t)(h * 256 + half * 128) * TM + b * NMEM; d.ldv = TM; d.Ow = BR + row0 * NBR + 2048 + h * 256 + half * 128; d.ldo = NBR;
            d.qpos0 = 0; d.kt0 = 0; d.kt1 = NMEM / 64; d.btab = 0; d.kcol0 = 0; d.sink2 = 0.f; d.lam = 0.f; d.subg = nullptr;
#ifndef SKIP_C
            att::attn_unit<256, 256, false, false, false, ATT_THR>(lds, d);
#endif
        }
        ATT_STAMP(14);
}

__global__ void __launch_bounds__(NWAVES * 64, 2) mega_fwd(Args args) {
    extern __shared__ __attribute__((aligned(16))) unsigned char lds_raw[];
    LAS unsigned char* lds = (LAS unsigned char*)lds_raw;
    volatile LAS unsigned* MISC = (volatile LAS unsigned*)(lds + MISC_OFF);
    const int tid = threadIdx.x, lane = tid & 63, wave = __builtin_amdgcn_readfirstlane(tid >> 6);
    const int G = gridDim.x, bx = blockIdx.x;
    const int vcu = (G % 8 == 0) ? (bx % 8) * (G / 8) + bx / 8 : bx;
    unsigned char* ws = args.ws;
    for (int u = tid; u < (LDS_BYTES - LDSCTL_OFF) / 4; u += NWAVES * 64) ((LAS unsigned*)(lds + LDSCTL_OFF))[u] = 0u;
    __syncthreads();
    XcdBarrier bar; bar.bar = (unsigned*)(ws + WS_CTL) + CW_BAR; bar.x = 0; bar.st = nullptr;
    if (N_LAUNCHES == 1) bar = xcd_barrier_post((unsigned*)(ws + WS_CTL) + CW_BAR, MISC + 8);
#define GRID_BAR() do { if (N_LAUNCHES == 1) xcd_barrier(bar); } while (0)
#ifdef PROBE_TS
    unsigned long long* const ts_ = (unsigned long long*)(ws + 32768);
#define STAMP(k) do { if (bx == 0 && tid == 0) ts_[k] = __builtin_amdgcn_s_memrealtime(); } while (0)
    STAMP(0);
#else
#define STAMP(k) do {} while (0)
#endif
    const int lo = args.ph_lo, hi = args.ph_hi;
#define IN(k) (lo <= (k) && (k) < hi)
    float* out = args.out;
    bf16* const Wbr_t = (bf16*)(ws + WS_WBR); bf16* const Wo_t = (bf16*)(ws + WS_WO); bf16* const WinQK_t = (bf16*)(ws + WS_WINQK); bf16* const WinV_t = (bf16*)(ws + WS_WINV);
    bf16* const Wgate_t = (bf16*)(ws + WS_WGATE); bf16* const Wmem_t = (bf16*)(ws + WS_WMEM); bf16* const H0b = (bf16*)(ws + WS_H0B); bf16* const MEMb = (bf16*)(ws + WS_MEMB);
    bf16* const QKP = (bf16*)(ws + WS_QKP); bf16* const VT = (bf16*)(ws + WS_VT); bf16* const MK = (bf16*)(ws + WS_MK); bf16* const MVT = (bf16*)(ws + WS_MVT);
    bf16* const GATES = (bf16*)(ws + WS_GATES); bf16* const BR = (bf16*)(ws + WS_BR); bf16* const MIXED = (bf16*)(ws + WS_MIXED);
    bf16* const H1b = (bf16*)(ws + WS_H1B); bf16* const Wup_t = (bf16*)(ws + WS_WUP); bf16* const Wdown_t = (bf16*)(ws + WS_WDOWN); bf16* const U = (bf16*)(ws + WS_U); bf16* const ACT = (bf16*)(ws + WS_ACT);
    const int gw = vcu * NWAVES + wave, NGW = G * NWAVES;
#define TJOBP(src, ldw, K, ncols, dst, ldt) { const int n_ = ((K) / 64) * ((ncols) / 64); if (r < n_) { transpose_item((src), (ldw), (K), (ncols), (dst), (ldt), r, lane); continue; } r -= n_; }
#define TJOB(src, ldw, K, ncols, dst) { const int n_ = ((K) / 64) * ((ncols) / 64); if (r < n_) { transpose_item((src), (ldw), (K), (ncols), (dst), (K), r, lane); continue; } r -= n_; }

    if (IN(0)) {
        const float* w_in = args.in[I_WIN];
        constexpr int I1 = 32 * 16, I2 = 32 * 4;
        constexpr int NIT = 5 * I1 + 2 * I2 + 32 * (NG / 64) + 32 * 32 + 3 * (16 * 32) + 32 * 32;
        for (int it = gw; it < NIT; it += NGW) {
            int r = it;
            TJOB(w_in + 0, IN_W, 2048, 1024, WinQK_t + (size_t)C_DQ * 2048)
            TJOB(w_in + 1024, IN_W, 2048, 1024, WinQK_t + (size_t)C_DK * 2048)
            TJOB(w_in + 2048, IN_W, 2048, 1024, WinV_t)
            TJOB(w_in + 3072, IN_W, 2048, 1024, WinQK_t + (size_t)C_WQ * 2048)
            TJOB(w_in + 4096, IN_W, 2048, 256, WinQK_t + (size_t)C_WK * 2048)
            TJOB(w_in + 4352, IN_W, 2048, 256, WinV_t + (size_t)1024 * 2048)
            TJOB(w_in + 4608, IN_W, 2048, 1024, WinQK_t + (size_t)C_MQ * 2048)
            TJOB(args.in[I_WGATE], NG, 2048, NG, Wgate_t)
            TJOB(args.in[I_WMEM], 2048, 2048, 2048, Wmem_t)
            TJOBP(args.in[I_WBR], 2048, 1024, 2048, Wbr_t, NBR)
            TJOBP(args.in[I_WBR] + (size_t)1024 * 2048, 2048, 1024, 2048, Wbr_t + 1024, NBR)
            TJOBP(args.in[I_WBR] + (size_t)2 * 1024 * 2048, 2048, 1024, 2048, Wbr_t + 2048, NBR)
            TJOB(args.in[I_WO], 2048, 2048, 2048, Wo_t)
        }
        for (int m = gw; m < T; m += NGW) ln_row(args.in[I_X] + (size_t)m * D, args.in[I_LNG], args.in[I_LNB], out + (size_t)m * D, H0b + (size_t)m * D, lane);
        for (int m = gw; m < TM; m += NGW) { const GAS f32x4* xr = (const GAS f32x4*)(args.in[I_MEM] + (size_t)m * D) + lane; GAS v2u* o = (GAS v2u*)(MEMb + (size_t)m * D) + lane;
#pragma unroll
            for (int j = 0; j < 8; ++j) { const f32x4 v = xr[64 * j]; o[64 * j] = (v2u){pk2(v.x, v.y), pk2(v.z, v.w)}; } }
        if (IN(1)) GRID_BAR();
        STAMP(1);
    }

    if (IN(1)) {
        pg8::Gemm g{nullptr, nullptr, 2048, 2048, 0, 0, 2048};
        pg8::MultiOrder S; S.G = G; S.c = bx;
        S.nM0 = T / 256;  S.nN0 = NG / 256;
        S.nM1 = T / 256;  S.nN1 = NQK / 256;
        S.nM2 = NV / 256; S.nN2 = T / 256;
        S.nM3 = TM / 256; S.nN3 = 1024 / 256;
        S.nM4 = 1024 / 256; S.nN4 = TM / 256;
        S.total = S.nM0 * S.nN0 + S.nM1 * S.nN1 + S.nM2 * S.nN2 + S.nM3 * S.nN3 + S.nM4 * S.nN4;
        pg8::MultiPtrs P{H0b, Wgate_t, H0b, WinQK_t, WinV_t, H0b, MEMb, Wmem_t, Wmem_t + (size_t)1024 * 2048, MEMb};
        pg8::EpiBf16Multi E{pg8::EpiBf16{GATES, NG, args.in[I_BGATE], 2, 1.f}, pg8::EpiBf16{QKP, NQK, nullptr, 0, 1.f}, pg8::EpiBf16{VT, T, nullptr, 0, 1.f}, pg8::EpiBf16{MK, 1024, nullptr, 0, 1.f}, pg8::EpiBf16{MVT, TM, nullptr, 0, 1.f},
                             0.125f * att::LOG2E, 0.08838834764831845f * att::LOG2E, 0.0625f * att::LOG2E};
        pg8::gemm_phase<pg8::EpiBf16Multi, pg8::MultiOrder, pg8::MultiPtrs>(lds, g, S, P, E);
        if (IN(2)) GRID_BAR();
        STAMP(2);
    }

    if (IN(2)) {
        phase_attention(lds, args, QKP, VT, MK, MVT, BR, vcu, G, wave, lane);
        if (IN(3)) GRID_BAR();
        STAMP(3);
    }

    if (IN(3)) {
        pg8::Gemm g{BR, Wbr_t, NBR, NBR, T, D, NBR};
        pg8::EpiGate E{GATES, NG, MIXED, D};
        pg8::StaticOrder S; S.init(T, D, G, bx); pg8::SinglePtrs P{g.A, g.Bt};
        pg8::gemm_phase<pg8::EpiGate, pg8::StaticOrder, pg8::SinglePtrs>(lds, g, S, P, E);
        if (IN(4)) GRID_BAR();
        STAMP(4);
    }

    if (IN(4)) {
        pg8::Gemm g{MIXED, Wo_t, 2048, 2048, T, D, 2048}; pg8::EpiResid E{out, D, ALPHA};
        pg8::StaticOrder S; S.init(T, D, G, bx); pg8::SinglePtrs P{g.A, g.Bt};
        pg8::gemm_phase<pg8::EpiResid, pg8::StaticOrder, pg8::SinglePtrs>(lds, g, S, P, E);
        if (IN(5)) GRID_BAR();
        STAMP(5);
    }

    if (IN(5)) {
        for (int m = gw; m < T; m += NGW) ln_row(out + (size_t)m * D, args.in[I_LN1G], args.in[I_LN1B], out + (size_t)m * D, H1b + (size_t)m * D, lane);
        constexpr int NIT = 32 * (NUP / 64) + (DFF / 64) * 32;
        for (int it = gw; it < NIT; it += NGW) {
            int r = it;
            TJOB(args.in[I_WUP], NUP, 2048, NUP, Wup_t)
            TJOB(args.in[I_WDOWN], 2048, DFF, 2048, Wdown_t)
        }
        if (IN(6)) GRID_BAR();
        STAMP(6);
    }

    if (IN(6)) {
        pg8::Gemm g{H1b, Wup_t, 2048, 2048, T, NUP, 2048}; pg8::EpiBf16 E; E.O = U; E.ldc = NUP; E.bias = nullptr; E.act = 0; E.scl = 1.f;
        pg8::StaticOrder S; S.init(T, NUP, G, bx); pg8::SinglePtrs P{g.A, g.Bt};
        pg8::gemm_phase<pg8::EpiBf16, pg8::StaticOrder, pg8::SinglePtrs>(lds, g, S, P, E);
        if (IN(7)) GRID_BAR();
        STAMP(7);
    }

    if (IN(7)) {
        const float* cw = args.in[I_CONVW]; const float* cb = args.in[I_CONVB];
        constexpr int NCH = DFF / 8, RUN = 8, NITEM = (T / RUN) * NCH;
        for (int item = bx * (NWAVES * 64) + tid; item < NITEM; item += G * NWAVES * 64) {
            const int tr = item / NCH, c = item % NCH, t0 = tr * RUN, n0 = c * 8;
            v4u ra[RUN + 2], rb[RUN + 2];
#pragma unroll
            for (int i = 0; i < RUN + 2; ++i) {
                const int t = t0 - 1 + i; const bool zero = (i == 0 && (t0 % SEQ) == 0) || (i == RUN + 1 && ((t0 + RUN) % SEQ) == 0);
                if (zero) { ra[i] = (v4u){0u, 0u, 0u, 0u}; rb[i] = (v4u){0u, 0u, 0u, 0u}; }
                else { ra[i] = *(const GAS v4u*)(U + (size_t)t * NUP + n0); rb[i] = *(const GAS v4u*)(U + (size_t)t * NUP + DFF + n0); }
            }
            float w0[16], w1[16], w2[16], bb[16];
#pragma unroll
            for (int e = 0; e < 8; ++e) { w0[e] = cw[n0 + e]; w1[e] = cw[NUP + n0 + e]; w2[e] = cw[2 * NUP + n0 + e]; bb[e] = cb[n0 + e];
                w0[8 + e] = cw[DFF + n0 + e]; w1[8 + e] = cw[NUP + DFF + n0 + e]; w2[8 + e] = cw[2 * NUP + DFF + n0 + e]; bb[8 + e] = cb[DFF + n0 + e]; }
#define UNPK(dst, a_, b_) do { dst[0] = bflo(a_.x); dst[1] = bfhi(a_.x); dst[2] = bflo(a_.y); dst[3] = bfhi(a_.y); dst[4] = bflo(a_.z); dst[5] = bfhi(a_.z); dst[6] = bflo(a_.w); dst[7] = bfhi(a_.w); \
                dst[8] = bflo(b_.x); dst[9] = bfhi(b_.x); dst[10] = bflo(b_.y); dst[11] = bfhi(b_.y); dst[12] = bflo(b_.z); dst[13] = bfhi(b_.z); dst[14] = bflo(b_.w); dst[15] = bfhi(b_.w); } while (0)
#pragma unroll
            for (int tt = 0; tt < RUN; ++tt) {
                float prev[16], cur[16], nxt[16];
                UNPK(prev, ra[tt], rb[tt]); UNPK(cur, ra[tt + 1], rb[tt + 1]); UNPK(nxt, ra[tt + 2], rb[tt + 2]);
                float o[8];
#pragma unroll
                for (int e = 0; e < 8; ++e) { const float val = prev[e] * w0[e] + cur[e] * w1[e] + nxt[e] * w2[e] + bb[e];
                    const float gt = prev[8 + e] * w0[8 + e] + cur[8 + e] * w1[8 + e] + nxt[8 + e] * w2[8 + e] + bb[8 + e]; o[e] = gelu_tanh(gt) * val; }
                *(GAS v4u*)(ACT + (size_t)(t0 + tt) * DFF + n0) = (v4u){pk2(o[0], o[1]), pk2(o[2], o[3]), pk2(o[4], o[5]), pk2(o[6], o[7])};
            }
#undef UNPK
        }
        if (IN(8)) GRID_BAR();
        STAMP(8);
    }

    if (IN(8)) {
        pg8::Gemm g{ACT, Wdown_t, DFF, DFF, T, D, DFF}; pg8::EpiResid E{out, D, ALPHA};
        pg8::StaticOrder S; S.init(T, D, G, bx); pg8::SinglePtrs P{g.A, g.Bt};
        pg8::gemm_phase<pg8::EpiResid, pg8::StaticOrder, pg8::SinglePtrs>(lds, g, S, P, E);
        if (IN(9)) GRID_BAR();
        STAMP(9);
    }

    if (IN(9)) {
        for (int m = gw; m < T; m += NGW) ln_row(out + (size_t)m * D, args.in[I_LN2G], args.in[I_LN2B], out + (size_t)m * D, nullptr, lane);
#ifdef PROBE_TS
        GRID_BAR(); STAMP(10);
        if (bx == 0 && tid == 0) {
            const unsigned long long* tsr = (const unsigned long long*)(ws + 32768);
            const unsigned long long da = tsr[PROBE_AE] - tsr[PROBE_A], db = tsr[PROBE_BE] - tsr[PROBE_B];
            const unsigned long long spin = 8ull * da + 8ull * db;
            const unsigned long long t0 = __builtin_amdgcn_s_memrealtime();
            while (__builtin_amdgcn_s_memrealtime() - t0 < spin) __builtin_amdgcn_s_sleep(8);
        }
#endif
    }
#undef IN
#undef TJOB
#undef TJOBP
#undef GRID_BAR
}

extern "C" void kernel_launch(void* const* d_in, const int* in_sizes, int n_in, void* d_out, int out_size, void* d_ws, size_t ws_size, hipStream_t stream) {
    static int grid = 0;
    if (grid == 0) {
        if (n_in != 25 || in_sizes[0] != T * D || out_size != T * D || ws_size < WS_END) { fprintf(stderr, "kernel_launch: unexpected shapes (n_in %d, in0 %d, out %d, ws %zu < %zu)\n", n_in, n_in > 0 ? in_sizes[0] : -1, out_size, ws_size, (size_t)WS_END); grid = -1; return; }
        int dev = 0, cus = 0, per_cu = 0;
        if (hipGetDevice(&dev) != hipSuccess || hipDeviceGetAttribute(&cus, hipDeviceAttributeMultiprocessorCount, dev) != hipSuccess) { fprintf(stderr, "kernel_launch: device query failed\n"); grid = -1; return; }
        if (hipFuncSetAttribute((const void*)mega_fwd, hipFuncAttributeMaxDynamicSharedMemorySize, LDS_BYTES) != hipSuccess) { fprintf(stderr, "kernel_launch: hipFuncSetAttribute failed\n"); grid = -1; return; }
        if (hipOccupancyMaxActiveBlocksPerMultiprocessor(&per_cu, (const void*)mega_fwd, NWAVES * 64, LDS_BYTES) != hipSuccess || per_cu < 1)
            fprintf(stderr, "kernel_launch: note: occupancy query reports %d workgroups per CU\n", per_cu);
        (void)hipGetLastError();
        grid = cus;
    }
    if (grid < 0) return;
    if (hipMemsetAsync((char*)d_ws + WS_CTL, 0, CTL_ZERO_BYTES, stream) != hipSuccess) { fprintf(stderr, "kernel_launch: memset failed\n"); return; }
    Args a{};
    for (int i = 0; i < 25; ++i) a.in[i] = (const float*)d_in[i];
    a.out = (float*)d_out; a.ws = (unsigned char*)d_ws;
    if (N_LAUNCHES == 1) { a.ph_lo = 0; a.ph_hi = N_PHASES; hipLaunchKernelGGL(mega_fwd, dim3(grid), dim3(NWAVES * 64), LDS_BYTES, stream, a); }
    else for (int li = 0; li < N_PHASES; ++li) { a.ph_lo = li; a.ph_hi = li + 1; hipLaunchKernelGGL(mega_fwd, dim3(grid), dim3(NWAVES * 64), LDS_BYTES, stream, a); }
    const hipError_t le = hipPeekAtLastError();
    if (le != hipSuccess) fprintf(stderr, "kernel_launch: launch failed: %s\n", hipGetErrorName(le));
}
```
